# Optimizing an MI355X kernel written in HIP

```python
import math
import jax, jax.numpy as jnp
from jax import lax
import numpy as np

D_MODEL = 1024
BATCH = 4
SEQ = 4096
DEPTH = 2

N_META = 16
BLOCK = 128
PAD = BLOCK - N_META
ROPE_THETA = 10000.0
NORM_EPS = 1e-6
MASK_VALUE = -1e30

MLA_HEADS = 8
MLA_Q_LORA = 256
MLA_KV_LORA = 128
MLA_NOPE = 64
MLA_ROPE = 32
MLA_V = 64
MLA_QK = MLA_NOPE + MLA_ROPE
SB_HEADS = 8
SB_HEAD_DIM = 64
DIFF_HEADS = 4
DIFF_HEAD_DIM = 64
DIFF_V_DIM = 2 * DIFF_HEAD_DIM
N_BRANCHES = 3
MLA_OUT = MLA_HEADS * MLA_V
SB_OUT = SB_HEADS * SB_HEAD_DIM
DIFF_QK = DIFF_HEADS * 2 * DIFF_HEAD_DIM
DIFF_OUT = DIFF_HEADS * DIFF_V_DIM
BRANCH_WIDTH = MLA_OUT + SB_OUT + DIFF_OUT
D_FF = 4 * D_MODEL
IN_SIZES = (MLA_Q_LORA, MLA_KV_LORA, MLA_ROPE,
            SB_OUT, SB_OUT, SB_OUT,
            DIFF_QK, DIFF_QK, DIFF_OUT,
            N_BRANCHES * D_MODEL)
IN_COLS = sum(IN_SIZES)

kernel_name = "hybrid_mla_stickbreak_diffattn_gated"


def _split_cols(t, sizes):
    outs, off = [], 0
    for s in sizes:
        outs.append(t[..., off:off + s])
        off += s
    return outs


def _rmsnorm(x, g):
    x32 = x.astype(jnp.float32)
    y = x32 * lax.rsqrt(jnp.mean(x32 * x32, axis=-1, keepdims=True) + NORM_EPS)
    return (y * g.astype(jnp.float32)).astype(x.dtype)


def _rope(x, pos):
    d = x.shape[-1]
    half = d // 2
    inv_freq = jnp.exp(-math.log(ROPE_THETA) * (2.0 * jnp.arange(half, dtype=jnp.float32) / d))
    ang = pos.astype(jnp.float32)[:, None] * inv_freq[None, :]
    cos = jnp.cos(ang).astype(x.dtype)
    sin = jnp.sin(ang).astype(x.dtype)
    x1, x2 = x[..., :half], x[..., half:]
    return jnp.concatenate([x1 * cos - x2 * sin, x1 * sin + x2 * cos], axis=-1)


def _heads(t, n_heads):
    b, p, _ = t.shape
    return t.reshape(b, p, n_heads, -1).transpose(0, 2, 1, 3)


def _to_blocks(t):
    b, h, p, d = t.shape
    return t.reshape(b, h, p // BLOCK, BLOCK, d).transpose(2, 0, 1, 3, 4)


def _from_blocks(o):
    nb, b, h, blk, d = o.shape
    return o.transpose(1, 0, 3, 2, 4).reshape(b, nb * blk, h * d)


def _scores(qb, k, scale):
    return jnp.einsum('bhqd,bhkd->bhqk', qb, k).astype(jnp.float32) * scale


def _masked_softmax(s, mask):
    return jax.nn.softmax(jnp.where(mask[None, None], s, MASK_VALUE), axis=-1)


def _softmax_attention(q, k, v, scale):
    p_len = q.shape[2]
    kidx = jnp.arange(p_len)
    kvalid = kidx >= PAD

    def block(args):
        qb, qi = args
        mask = (kidx[None, :] <= qi[:, None]) & kvalid[None, :]
        p = _masked_softmax(_scores(qb, k, scale), mask)
        return jnp.einsum('bhqk,bhkd->bhqd', p.astype(v.dtype), v)

    return _from_blocks(lax.map(block, (_to_blocks(q), kidx.reshape(-1, BLOCK))))


def _stick_breaking_attention(q, k, v):
    p_len = q.shape[2]
    scale = q.shape[-1] ** -0.5
    kidx = jnp.arange(p_len)
    kvalid = kidx >= PAD

    def block(args):
        qb, qi = args
        z = _scores(qb, k, scale)
        mask = ((kidx[None, :] < qi[:, None]) & kvalid[None, :])[None, None]
        log_keep = jnp.where(mask, jax.nn.log_sigmoid(-z), 0.0)
        suffix = lax.cumsum(log_keep, axis=3, reverse=True) - log_keep
        a = jnp.where(mask, jnp.exp(jax.nn.log_sigmoid(z) + suffix), 0.0)
        return jnp.einsum('bhqk,bhkd->bhqd', a.astype(v.dtype), v)

    return _from_blocks(lax.map(block, (_to_blocks(q), kidx.reshape(-1, BLOCK))))


def _differential_attention(q1, q2, k1, k2, v, lam):
    p_len = q1.shape[2]
    scale = q1.shape[-1] ** -0.5
    kidx = jnp.arange(p_len)
    kvalid = kidx >= PAD

    def block(args):
        q1b, q2b, qi = args
        mask = (kidx[None, :] <= qi[:, None]) & kvalid[None, :]
        p1 = _masked_softmax(_scores(q1b, k1, scale), mask)
        p2 = _masked_softmax(_scores(q2b, k2, scale), mask)
        w = p1 - lam * p2
        return jnp.einsum('bhqk,bhkd->bhqd', w.astype(v.dtype), v)

    return _from_blocks(lax.map(block, (_to_blocks(q1), _to_blocks(q2), kidx.reshape(-1, BLOCK))))


def setup_inputs(seed: int = 0) -> dict:
    key = jax.random.key(seed)
    ks = jax.random.split(key, 24)
    f32 = jnp.float32

    def nrm(k, shape, scale):
        return jax.random.normal(k, shape, f32) * scale

    def gain(k, shape):
        return 1.0 + 0.02 * jax.random.normal(k, shape, f32)

    return {
        "x": jax.random.normal(ks[0], (BATCH, SEQ, D_MODEL), f32),
        "meta_tokens": nrm(ks[1], (N_META, D_MODEL), 1.0),
        "ln1_g": gain(ks[2], (DEPTH, D_MODEL)),
        "w_in": nrm(ks[3], (DEPTH, D_MODEL, IN_COLS), D_MODEL ** -0.5),
        "mla_cq_norm_g": gain(ks[4], (DEPTH, MLA_Q_LORA)),
        "mla_ckv_norm_g": gain(ks[5], (DEPTH, MLA_KV_LORA)),
        "mla_w_uq": nrm(ks[6], (DEPTH, MLA_Q_LORA, MLA_HEADS * MLA_QK), MLA_Q_LORA ** -0.5),
        "mla_w_ukv": nrm(ks[7], (DEPTH, MLA_KV_LORA, MLA_HEADS * (MLA_NOPE + MLA_V)), MLA_KV_LORA ** -0.5),
        "mla_q_norm_g": gain(ks[8], (DEPTH, MLA_QK)),
        "mla_k_norm_g": gain(ks[9], (DEPTH, MLA_QK)),
        "diff_q_norm_g": gain(ks[10], (DEPTH, DIFF_HEAD_DIM)),
        "diff_k_norm_g": gain(ks[11], (DEPTH, DIFF_HEAD_DIM)),
        "diff_lambda": nrm(ks[12], (DEPTH, 4, DIFF_HEAD_DIM), 0.1),
        "diff_out_norm_g": gain(ks[13], (DEPTH, DIFF_V_DIM)),
        "gate_b": nrm(ks[14], (DEPTH, N_BRANCHES * D_MODEL), 0.02),
        "w_branch": nrm(ks[15], (DEPTH, BRANCH_WIDTH, D_MODEL), MLA_OUT ** -0.5),
        "w_out": nrm(ks[16], (DEPTH, D_MODEL, D_MODEL), D_MODEL ** -0.5),
        "ln2_g": gain(ks[17], (DEPTH, D_MODEL)),
        "w_ff1": nrm(ks[18], (DEPTH, D_MODEL, D_FF), D_MODEL ** -0.5),
        "w_ff2": nrm(ks[19], (DEPTH, D_FF, D_MODEL), D_FF ** -0.5),
    }


def reference(x, meta_tokens, ln1_g, w_in, mla_cq_norm_g, mla_ckv_norm_g, mla_w_uq, mla_w_ukv,
              mla_q_norm_g, mla_k_norm_g, diff_q_norm_g, diff_k_norm_g, diff_lambda,
              diff_out_norm_g, gate_b, w_branch, w_out, ln2_g, w_ff1, w_ff2):
    b, seq, d = x.shape
    pad = jnp.zeros((b, PAD, d), x.dtype)
    meta = jnp.broadcast_to(meta_tokens.astype(x.dtype)[None], (b, N_META, d))
    h_res = jnp.concatenate([pad, meta, x], axis=1)
    p_len = h_res.shape[1]
    pos = jnp.maximum(jnp.arange(p_len) - PAD, 0)

    for layer in range(DEPTH):
        h = _rmsnorm(h_res, ln1_g[layer])
        proj = h @ w_in[layer]
        (c_q, c_kv, k_rope, sb_q, sb_k, sb_v,
         df_q, df_k, df_v, gate_logits) = _split_cols(proj, IN_SIZES)

        q = _heads(_rmsnorm(c_q, mla_cq_norm_g[layer]) @ mla_w_uq[layer], MLA_HEADS)
        kv = _heads(_rmsnorm(c_kv, mla_ckv_norm_g[layer]) @ mla_w_ukv[layer], MLA_HEADS)
        k_nope, v_mla = kv[..., :MLA_NOPE], kv[..., MLA_NOPE:]
        k_r = jnp.broadcast_to(k_rope[:, None], (b, MLA_HEADS, p_len, MLA_ROPE))
        k = jnp.concatenate([k_nope, k_r], axis=-1)
        q = _rmsnorm(q, mla_q_norm_g[layer])
        k = _rmsnorm(k, mla_k_norm_g[layer])
        q = jnp.concatenate([q[..., :MLA_NOPE], _rope(q[..., MLA_NOPE:], pos)], axis=-1)
        k = jnp.concatenate([k[..., :MLA_NOPE], _rope(k[..., MLA_NOPE:], pos)], axis=-1)
        out_a = _softmax_attention(q, k, v_mla, MLA_QK ** -0.5)

        out_b = _stick_breaking_attention(_heads(sb_q, SB_HEADS), _heads(sb_k, SB_HEADS),
                                          _heads(sb_v, SB_HEADS))

        dq = _heads(df_q, DIFF_HEADS)
        dk = _heads(df_k, DIFF_HEADS)
        dv = _heads(df_v, DIFF_HEADS)
        qn, kn = diff_q_norm_g[layer], diff_k_norm_g[layer]
        q1 = _rope(_rmsnorm(dq[..., :DIFF_HEAD_DIM], qn), pos)
        q2 = _rope(_rmsnorm(dq[..., DIFF_HEAD_DIM:], qn), pos)
        k1 = _rope(_rmsnorm(dk[..., :DIFF_HEAD_DIM], kn), pos)
        k2 = _rope(_rmsnorm(dk[..., DIFF_HEAD_DIM:], kn), pos)
        lam_init = 0.8 - 0.6 * math.exp(-0.3 * layer)
        lp = diff_lambda[layer].astype(jnp.float32)
        lam = jnp.exp(jnp.sum(lp[0] * lp[1])) - jnp.exp(jnp.sum(lp[2] * lp[3])) + lam_init
        o_c = _differential_attention(q1, q2, k1, k2, dv, lam)
        o_c = _rmsnorm(o_c.reshape(b, p_len, DIFF_HEADS, DIFF_V_DIM), diff_out_norm_g[layer])
        out_c = (o_c * (1.0 - lam_init)).reshape(b, p_len, DIFF_OUT)

        gates = jax.nn.sigmoid(gate_logits + gate_b[layer]).reshape(b, p_len, N_BRANCHES, d)
        wb_a, wb_b, wb_c = _split_cols(w_branch[layer].T, (MLA_OUT, SB_OUT, DIFF_OUT))
        merged = (gates[:, :, 0] * (out_a @ wb_a.T)
                  + gates[:, :, 1] * (out_b @ wb_b.T)
                  + gates[:, :, 2] * (out_c @ wb_c.T))
        h_res = h_res + merged @ w_out[layer]

        h2 = _rmsnorm(h_res, ln2_g[layer])
        h_res = h_res + jnp.square(jax.nn.relu(h2 @ w_ff1[layer])) @ w_ff2[layer]

    return h_res[:, PAD + N_META:]
```

```cpp
#include <hip/hip_runtime.h>
#include <hip/hip_cooperative_groups.h>
#include <stdint.h>
#include <stdio.h>
namespace cg = cooperative_groups;

typedef unsigned short bf16_t;
typedef short bf16x8 __attribute__((ext_vector_type(8)));
typedef short s16x4 __attribute__((ext_vector_type(4)));
typedef float f32x16 __attribute__((ext_vector_type(16)));
typedef unsigned u32x2 __attribute__((ext_vector_type(2)));
typedef unsigned u32x4 __attribute__((ext_vector_type(4)));
typedef float f32x4 __attribute__((ext_vector_type(4)));
#define DEVI __device__ __forceinline__
#define LAS __attribute__((address_space(3)))
typedef LAS const char* lds_cptr;
typedef __attribute__((address_space(1))) unsigned short gbf16_t;
typedef __attribute__((address_space(1))) float gf32_t;
typedef short v4i16_t __attribute__((ext_vector_type(4)));

constexpr int DM = 1024, NB_ = 4, SEQ = 4096, PLEN = 4224, MROWS = NB_ * PLEN, NQT = 33, PADN = 112, NMETA = 16;
constexpr int IN_COLS = 6560, NMAIN = 3488, PROJ_LD = 3584;
constexpr int C_CQ = 0, C_CKV = 256, C_KR = 384, C_SBQ = 416, C_SBK = 928, C_SBV = 1440, C_DQ = 1952, C_DK = 2464, C_DV = 2976;
constexpr float EPS = 1e-6f, LOG2E = 1.4426950408889634f;
constexpr int NTHREADS = 256;
constexpr int NREAL = NB_ * SEQ, MT_REAL = NREAL / 128;

constexpr size_t OFF_BAR = 0;
constexpr size_t ZERO_BYTES = 32768;
constexpr size_t OFF_CONST = 32768;
constexpr size_t OFF_META = 65536;
constexpr size_t OFF_PART = OFF_META + 64 * 1024 * 4;
constexpr size_t OFF_PCQ = OFF_PART + (size_t)MROWS * 16 * 4;
constexpr size_t OFF_PCKV = OFF_PCQ + (size_t)MROWS * 4 * 4;
constexpr size_t OFF_W = 2u << 20;
constexpr size_t W_IN = 0, W_GATE = W_IN + (size_t)PROJ_LD * 1024, W_UQ = W_GATE + (size_t)3072 * 1024, W_UKV = W_UQ + 768 * 256,
                 W_BA = W_UKV + 1024 * 128, W_BB = W_BA + 1024 * 768, W_BC = W_BB + 1024 * 512, W_OUT = W_BC + 1024 * 512,
                 W_FF1 = W_OUT + 1024 * 1024, W_FF2 = W_FF1 + (size_t)4096 * 1024, W_END = W_FF2 + (size_t)4096 * 1024;
constexpr size_t OFF_HB = OFF_W + W_END * 2;
constexpr size_t OFF_PROJ = OFF_HB + (size_t)MROWS * 1024 * 2;
constexpr size_t OFF_MQ = OFF_PROJ + (size_t)MROWS * PROJ_LD * 2;
constexpr size_t OFF_MK = OFF_MQ + (size_t)MROWS * 768 * 2;
constexpr size_t OFF_MV = OFF_MK + (size_t)MROWS * 768 * 2;
constexpr size_t WS_NEED = OFF_MV + (size_t)MROWS * 512 * 2;
constexpr size_t OFF_MERGED = OFF_MK;
constexpr size_t OFF_FF = OFF_PROJ;
static_assert((size_t)MROWS * 1024 * 2 <= (size_t)MROWS * (768 + 512) * 2, "merged fits");
static_assert((size_t)MROWS * 4096 * 2 <= (size_t)MROWS * (PROJ_LD + 768) * 2, "ff fits");

struct Params {
    const float *x, *meta, *ln1_g, *w_in, *cq_g, *ckv_g, *w_uq, *w_ukv, *mq_g, *mk_g, *dq_g, *dk_g, *dlam, *dout_g, *gate_b, *w_br, *w_out, *ln2_g, *w_ff1, *w_ff2;
    float* out; char* ws; int ph_lo, ph_hi, use_bar, never, tid, pad2;
};

DEVI unsigned cvt_pk(float lo, float hi) { unsigned r; asm("v_cvt_pk_bf16_f32 %0, %1, %2" : "=v"(r) : "v"(lo), "v"(hi)); return r; }
DEVI float bf2f(unsigned h) { return __uint_as_float(h << 16); }
DEVI int crow(int r, int hi) { return (r & 3) + 8 * (r >> 2) + 4 * hi; }
DEVI float* rowptr(const Params& p, int m) {
    if (m < NREAL) return p.out + (size_t)m * DM;
    const int i = (m - NREAL) & 127, b = (m - NREAL) >> 7;
    if (i >= PADN) return (float*)(p.ws + OFF_META) + (size_t)(b * NMETA + i - PADN) * DM;
    return nullptr;
}
#define MFMA(a, b, c) __builtin_amdgcn_mfma_f32_32x32x16_bf16(a, b, c, 0, 0, 0)

#define XB_TMO      128
#define XB_XCNT(j)  (256  + 64 * (j))
#define XB_XSUB(j)  (1280 + 64 * (j))
#define XB_XGEN(j)  (2304 + 64 * (j))
#define XB_TOP      3328
#define XB_TOPGEN   3392
#define XB_QUEUE(l) (4096 + 64 * (l))
#define XB_SPIN_CAP (1u << 22)
DEVI unsigned xb_ld(unsigned* p) { return __hip_atomic_load(p, __ATOMIC_RELAXED, __HIP_MEMORY_SCOPE_AGENT); }
DEVI unsigned xb_add(unsigned* p, unsigned v) { return __hip_atomic_fetch_add(p, v, __ATOMIC_RELAXED, __HIP_MEMORY_SCOPE_AGENT); }
DEVI unsigned xb_xcc_id() { return (unsigned)__builtin_amdgcn_s_getreg((3 << 11) | 20) & 0xFu; }
#define XB_SPIN(cond, bar) do { unsigned _sp = 0; while (cond) { __builtin_amdgcn_s_sleep(1); \
    if ((++_sp & 255u) == 0u) { if (xb_ld(&(bar)[XB_TMO])) break; if (_sp > XB_SPIN_CAP) { atomicAdd(&(bar)[XB_TMO], 1u); break; } } } } while (0)
struct XcdBarrier { unsigned* bar; unsigned x; volatile LAS unsigned* st; };
DEVI XcdBarrier xcd_barrier_post(unsigned* bar, volatile LAS unsigned* st) {
    XcdBarrier b; b.bar = bar; b.x = xb_xcc_id(); b.st = st;
    if (threadIdx.x == 0) (void)xb_add(&bar[XB_XCNT(b.x)], 1u);
    return b;
}
DEVI void xcd_barrier_complete(unsigned* bar, unsigned x, unsigned& nloc, unsigned& nx) {
    const unsigned G = gridDim.x * gridDim.y * gridDim.z;
    unsigned sum, cnt, mine, sp = 0u;
    for (;;) {
        sum = 0u; cnt = 0u; mine = 0u;
#pragma unroll
        for (unsigned j = 0; j < 16; ++j) { const unsigned c = xb_ld(&bar[XB_XCNT(j)]); sum += c; cnt += (c > 0u) ? 1u : 0u; mine = (j == x) ? c : mine; }
        if (sum == G) break;
        __builtin_amdgcn_s_sleep(1);
        if ((++sp & 255u) == 0u) { if (xb_ld(&bar[XB_TMO])) break; if (sp > XB_SPIN_CAP) { atomicAdd(&bar[XB_TMO], 1u); break; } }
    }
    nloc = mine > 0u ? mine : 1u; nx = cnt > 0u ? cnt : 1u;
}
DEVI void xcd_barrier(const XcdBarrier& b) {
    asm volatile("s_waitcnt vmcnt(0)" ::: "memory");
    __syncthreads();
    if (threadIdx.x == 0) {
        unsigned* bar = b.bar;
        __builtin_amdgcn_s_waitcnt(0);
        unsigned nloc = b.st[0], nx = b.st[1];
        if (nloc == 0u) { xcd_barrier_complete(bar, b.x, nloc, nx); b.st[0] = nloc; b.st[1] = nx; }
        const unsigned old = xb_add(&bar[XB_XSUB(b.x)], 1u);
        const unsigned gen = old / nloc;
        if (old + 1u == (gen + 1u) * nloc) {
            __builtin_amdgcn_fence(__ATOMIC_RELEASE, "agent");
            asm volatile("s_waitcnt vmcnt(0)" ::: "memory");
            const unsigned og = xb_add(&bar[XB_TOP], 1u);
            const unsigned tg = og / nx;
            if (og + 1u == (tg + 1u) * nx) xb_add(&bar[XB_TOPGEN], 1u);
            else XB_SPIN(xb_ld(&bar[XB_TOPGEN]) == tg, bar);
            __builtin_amdgcn_fence(__ATOMIC_ACQUIRE, "agent");
            xb_add(&bar[XB_XGEN(b.x)], 1u);
            asm volatile("s_waitcnt vmcnt(0)" ::: "memory");
        } else {
            XB_SPIN(xb_ld(&bar[XB_XGEN(b.x)]) == gen, bar);
            __builtin_amdgcn_fence(__ATOMIC_ACQUIRE, "agent");
            asm volatile("s_waitcnt vmcnt(0)" ::: "memory");
        }
    }
    __syncthreads();
}

DEVI void glds16(const void* g, unsigned lds_base) {
    unsigned sv; asm volatile("s_mov_b32 %0, m0\n\ts_mov_b32 m0, %2\n\ts_nop 0\n\tglobal_load_lds_dwordx4 %1, off\n\ts_mov_b32 m0, %0" : "=&s"(sv) : "v"(g), "s"(lds_base) : "memory"); }
template <int NB, int BK = (NB == 4 ? 32 : 64), int NST = (NB == 4 ? 3 : 2)>
DEVI void gemm_acc(const int TID, const bf16_t* __restrict__ A, int lda, const bf16_t* __restrict__ Bt, int ldb, int K, f32x16 (&acc)[2][NB], char* lds) {
    constexpr int ROWB = BK * 2, SLOTS = ROWB / 16, RPP = 1024 / ROWB, NA = 128 / RPP / 4, NBI = 64 * NB / RPP / 4, NI = NA + NBI, KS = BK / 16;
    constexpr int BOFF = 128 * ROWB, STAGE = (128 + 64 * NB) * ROWB;
    static_assert(NST * STAGE <= 73728, "LDS ring too large");
    const int tid = TID, lane = tid & 63, w = __builtin_amdgcn_readfirstlane(tid >> 6), wm = w >> 1, wn = w & 1, hi = lane >> 5, l32 = lane & 31;
    const int gsw = BK == 64 ? ((4 * (w & 1) + (lane >> 4)) & 7) : ((lane >> 4) & 3);
    const int gc = (lane % SLOTS) ^ gsw;
    const bf16_t* ag = A + (size_t)(RPP * w + lane / SLOTS) * lda + gc * 8;
    const bf16_t* bg = Bt + (size_t)(RPP * w + lane / SLOTS) * ldb + gc * 8;
    const int sw = BK == 64 ? ((l32 >> 1) & 7) : ((l32 >> 2) & 3);
    const int arow = (wm * 64 + l32) * ROWB, brow = BOFF + (wn * 32 * NB + l32) * ROWB;
    const int nk = K / BK;
    const unsigned lds0 = (unsigned)(uintptr_t)lds + w * 1024;
#define GEMM_ISSUE(kt_) do { const unsigned sd = (unsigned)__builtin_amdgcn_readfirstlane(lds0 + ((kt_) % NST) * STAGE); const int ko = (kt_) * BK; \
        _Pragma("unroll") for (int i = 0; i < NA; ++i) glds16(ag + (size_t)(4 * RPP * i) * lda + ko, sd + i * 4096); \
        _Pragma("unroll") for (int i = 0; i < NBI; ++i) glds16(bg + (size_t)(4 * RPP * i) * ldb + ko, sd + BOFF + i * 4096); } while (0)
#pragma unroll
    for (int i = 0; i < NST - 1; ++i) if (i < nk) GEMM_ISSUE(i);
    if (NST == 1) GEMM_ISSUE(0);
#pragma unroll 1
    for (int kt = 0; kt < nk; ++kt) {
        if (NST == 3 && kt + 1 < nk) asm volatile("s_waitcnt vmcnt(%0)\n\ts_barrier" :: "n"(NI) : "memory");
        else asm volatile("s_waitcnt vmcnt(0)\n\ts_barrier" ::: "memory");
        const char* st = lds + (kt % NST) * STAGE;
        bf16x8 af[KS][2], bfr[KS][NB];
#define GEMM_RD(ks_) do { const int ch = ((2 * (ks_) + hi) ^ sw) << 4; \
            af[ks_][0] = *(const bf16x8*)(st + arow + ch); af[ks_][1] = *(const bf16x8*)(st + arow + 32 * ROWB + ch); \
            _Pragma("unroll") for (int nb = 0; nb < NB; ++nb) bfr[ks_][nb] = *(const bf16x8*)(st + brow + nb * 32 * ROWB + ch); } while (0)
        GEMM_RD(0);
        __builtin_amdgcn_sched_barrier(0);
        if (NST > 1 && kt + NST - 1 < nk) GEMM_ISSUE(kt + NST - 1);
#pragma unroll
        for (int ks = 0; ks < KS; ++ks) {
            if (ks + 1 < KS) GEMM_RD(ks + 1);
#pragma unroll
            for (int nb = 0; nb < NB; ++nb) {
                acc[0][nb] = MFMA(af[ks][0], bfr[ks][nb], acc[0][nb]);
                acc[1][nb] = MFMA(af[ks][1], bfr[ks][nb], acc[1][nb]);
            }
            if (ks + 1 < KS) {
#pragma unroll
                for (int g = 0; g < (2 + NB + 1) / 2; ++g) { __builtin_amdgcn_sched_group_barrier(0x008, 2, 0); __builtin_amdgcn_sched_group_barrier(0x100, 2, 0); }
            }
            __builtin_amdgcn_sched_group_barrier(0x008, 2 * NB, 0);
            __builtin_amdgcn_sched_barrier(0);
        }
#undef GEMM_RD
        if (NST == 1 && kt + 1 < nk) { asm volatile("s_waitcnt lgkmcnt(0)\n\ts_barrier" ::: "memory"); GEMM_ISSUE(kt + 1); }
    }
    asm volatile("s_waitcnt lgkmcnt(0)\n\ts_barrier" ::: "memory");
#undef GEMM_ISSUE
}
template <int NB> DEVI void zero_acc(f32x16 (&acc)[2][NB]) {
#pragma unroll
    for (int a = 0; a < 2; ++a)
#pragma unroll
        for (int b = 0; b < NB; ++b)
#pragma unroll
            for (int r = 0; r < 16; ++r) acc[a][b][r] = 0.f;
}
DEVI void compute_rinv(const int TID, float* rinv, const float* part, int stride, int n, float div, int m0) {
    __syncthreads();
    const int t = TID;
    if (t < 128) {
        float s = 0.f;
        if (part) { for (int j = 0; j < n; ++j) s += part[(size_t)(m0 + t) * stride + j]; rinv[t] = rsqrtf(s / div + EPS); }
        else rinv[t] = 1.f;
    }
    __syncthreads();
}

DEVI void convert_tile(const int TID, const float* __restrict__ W, int ldw, int n0, int N, bf16_t* __restrict__ Wt, int Kdst, int tn, int tk, int kind,
                       const float* __restrict__ ks, float kconst, float* tile) {
    const int t = TID;
    const int nn = (t & 15) * 4;
#pragma unroll
    for (int i = 0; i < 4; ++i) {
        const int kk = (t >> 4) + 16 * i, kd = tk * 64 + kk;
        int sk = kd;
        if (kind == 4) { const int h = kd / 96, d = kd - h * 96; sk = d < 64 ? h * 64 + d : -1; }
        const int n = tn * 64 + nn;
        float4 v = make_float4(0.f, 0.f, 0.f, 0.f);
        if (sk >= 0 && n < N) {
            v = *(const float4*)(W + (size_t)sk * ldw + n0 + n);
            float s = kconst;
            if (ks) s *= (kind == 6) ? ks[sk & 127] : ks[sk];
            if (kind == 0 && n >= C_SBQ && n < C_SBK) s *= 0.125f * LOG2E;
            v.x *= s; v.y *= s; v.z *= s; v.w *= s;
        }
        float* d = tile + kk * 65 + nn;
        d[0] = v.x; d[1] = v.y; d[2] = v.z; d[3] = v.w;
    }
    __syncthreads();
    {
        const int n = t >> 2, kq = t & 3;
        unsigned pk[8];
#pragma unroll
        for (int j = 0; j < 8; ++j) pk[j] = cvt_pk(tile[(16 * kq + 2 * j) * 65 + n], tile[(16 * kq + 2 * j + 1) * 65 + n]);
        bf16_t* dst = Wt + (size_t)(tn * 64 + n) * Kdst + tk * 64 + 16 * kq;
        *(uint4*)dst = make_uint4(pk[0], pk[1], pk[2], pk[3]);
        *(uint4*)(dst + 8) = make_uint4(pk[4], pk[5], pk[6], pk[7]);
    }
    __syncthreads();
}

DEVI void phase_prep(const Params& p, int layer, char* lds) {
    bf16_t* Wb = (bf16_t*)(p.ws + OFF_W);
    float* tile = (float*)lds;
    const float lam_init = 0.8f - 0.6f * expf(-0.3f * (float)layer);
    struct Job { const float* W; const float* ks; bf16_t* Wt; int ldw, n0, N, Kdst, nt; float kc; };
    Job* jobs = (Job*)(lds + 32768);
    __syncthreads();
    if (p.tid < 10) {
        const int j = p.tid;
        Job jb; jb.n0 = 0; jb.ks = nullptr; jb.kc = 1.f; jb.ldw = 1024; jb.N = 1024; jb.Kdst = 1024;
        if (j == 0) { jb.W = p.w_in + (size_t)layer * DM * IN_COLS; jb.ldw = IN_COLS; jb.N = NMAIN; jb.Wt = Wb + W_IN; jb.ks = p.ln1_g + layer * DM; jb.nt = 56 * 16; }
        else if (j == 1) { jb.W = p.w_in + (size_t)layer * DM * IN_COLS; jb.ldw = IN_COLS; jb.n0 = NMAIN; jb.N = 3072; jb.Wt = Wb + W_GATE; jb.ks = p.ln1_g + layer * DM; jb.nt = 48 * 16; }
        else if (j == 2) { jb.W = p.w_uq + (size_t)layer * 256 * 768; jb.ldw = 768; jb.N = 768; jb.Kdst = 256; jb.Wt = Wb + W_UQ; jb.ks = p.cq_g + layer * 256; jb.nt = 12 * 4; }
        else if (j == 3) { jb.W = p.w_ukv + (size_t)layer * 128 * 1024; jb.Kdst = 128; jb.Wt = Wb + W_UKV; jb.ks = p.ckv_g + layer * 128; jb.nt = 16 * 2; }
        else if (j == 4) { jb.W = p.w_br + (size_t)layer * 1536 * 1024; jb.Kdst = 768; jb.Wt = Wb + W_BA; jb.nt = 16 * 12; }
        else if (j == 5) { jb.W = p.w_br + (size_t)layer * 1536 * 1024 + (size_t)512 * 1024; jb.Kdst = 512; jb.Wt = Wb + W_BB; jb.nt = 16 * 8; }
        else if (j == 6) { jb.W = p.w_br + (size_t)layer * 1536 * 1024 + (size_t)1024 * 1024; jb.Kdst = 512; jb.Wt = Wb + W_BC; jb.ks = p.dout_g + layer * 128; jb.kc = 1.f - lam_init; jb.nt = 16 * 8; }
        else if (j == 7) { jb.W = p.w_out + (size_t)layer * DM * DM; jb.Wt = Wb + W_OUT; jb.nt = 16 * 16; }
        else if (j == 8) { jb.W = p.w_ff1 + (size_t)layer * DM * 4096; jb.ldw = 4096; jb.N = 4096; jb.Wt = Wb + W_FF1; jb.ks = p.ln2_g + layer * DM; jb.nt = 64 * 16; }
        else { jb.W = p.w_ff2 + (size_t)layer * 4096 * DM; jb.Kdst = 4096; jb.Wt = Wb + W_FF2; jb.nt = 16 * 64; }
        jobs[j] = jb;
    }
    __syncthreads();
    int cum = 0;
#pragma unroll 1
    for (int j = 0; j < 10; ++j) {
        const Job jb = jobs[j];
        const int nkt = jb.Kdst / 64, G = (int)gridDim.x;
        const int t0 = ((int)blockIdx.x + G - (cum % G)) % G;
        for (int tt = t0; tt < jb.nt; tt += G) convert_tile(p.tid, jb.W, jb.ldw, jb.n0, jb.N, jb.Wt, jb.Kdst, tt / nkt, tt % nkt, j, jb.ks, jb.kc, tile);
        cum += jb.nt;
    }
    if (blockIdx.x == 0 && p.tid < 64) {
        const int l = p.tid;
        float a = fmaxf(fabsf(p.mq_g[layer * 96 + l]), l < 32 ? fabsf(p.mq_g[layer * 96 + 64 + l]) : 0.f);
        float b = fmaxf(fabsf(p.mk_g[layer * 96 + l]), l < 32 ? fabsf(p.mk_g[layer * 96 + 64 + l]) : 0.f);
        float c = fabsf(p.dq_g[layer * 64 + l]), d = fabsf(p.dk_g[layer * 64 + l]);
        const float* lp = p.dlam + layer * 256;
        float s1 = lp[l] * lp[64 + l], s2 = lp[128 + l] * lp[192 + l];
#pragma unroll
        for (int o = 32; o >= 1; o >>= 1) {
            a = fmaxf(a, __shfl_xor(a, o)); b = fmaxf(b, __shfl_xor(b, o)); c = fmaxf(c, __shfl_xor(c, o)); d = fmaxf(d, __shfl_xor(d, o));
            s1 += __shfl_xor(s1, o); s2 += __shfl_xor(s2, o);
        }
        if (l == 0) {
            float* cs = (float*)(p.ws + OFF_CONST) + layer * 16;
            cs[0] = sqrtf(96.f) * a * b * LOG2E;
            cs[1] = 8.f * c * d * LOG2E;
            cs[2] = expf(s1) - expf(s2) + lam_init;
        }
    }
    if (layer == 0) {
        bf16_t* hb = (bf16_t*)(p.ws + OFF_HB);
        float* part = (float*)(p.ws + OFF_PART);
        const int lane = p.tid & 63, wv = blockIdx.x * 4 + (p.tid >> 6), nwv = gridDim.x * 4;
        for (int m = wv; m < MROWS; m += nwv) {
            f32x4 v[4];
            const int mi = (m - NREAL) & 127;
            const float* src = m < NREAL ? p.x + (size_t)m * DM : (mi >= PADN ? p.meta + (size_t)(mi - PADN) * DM : nullptr);
#pragma unroll
            for (int i = 0; i < 4; ++i) v[i] = src ? *(const f32x4*)(src + lane * 16 + i * 4) : (f32x4){0.f, 0.f, 0.f, 0.f};
            float* dst = rowptr(p, m);
            float s = 0.f;
#pragma unroll
            for (int i = 0; i < 4; ++i) {
                if (dst) *(f32x4*)(dst + lane * 16 + i * 4) = v[i];
                s += v[i].x * v[i].x + v[i].y * v[i].y + v[i].z * v[i].z + v[i].w * v[i].w;
            }
            u32x4 h0 = (u32x4){cvt_pk(v[0].x, v[0].y), cvt_pk(v[0].z, v[0].w), cvt_pk(v[1].x, v[1].y), cvt_pk(v[1].z, v[1].w)};
            u32x4 h1 = (u32x4){cvt_pk(v[2].x, v[2].y), cvt_pk(v[2].z, v[2].w), cvt_pk(v[3].x, v[3].y), cvt_pk(v[3].z, v[3].w)};
            *(u32x4*)(hb + (size_t)m * DM + lane * 16) = h0;
            *(u32x4*)(hb + (size_t)m * DM + lane * 16 + 8) = h1;
            s += __shfl_xor(s, 1); s += __shfl_xor(s, 2);
            if ((lane & 3) == 0) part[(size_t)m * 16 + (lane >> 2)] = s;
        }
    }
}


typedef float f32x4v __attribute__((ext_vector_type(4)));
DEVI int meta_row0(int b) { return NREAL + b * 128 + PADN; }
DEVI void mini_gemm(const int TID, const bf16_t* __restrict__ A, int lda, const bf16_t* __restrict__ Wt, int ldb, int K, float (&v)[4], char* lds) {
    const int lane = TID & 63, w = TID >> 6, r16 = lane & 15, kg = lane >> 4, kq = K >> 2;
    f32x4v acc[4];
#pragma unroll
    for (int cb = 0; cb < 4; ++cb) acc[cb] = (f32x4v){0.f, 0.f, 0.f, 0.f};
    const bf16_t* ap = A + (size_t)r16 * lda + w * kq + kg * 8;
    const bf16_t* bp = Wt + (size_t)r16 * ldb + w * kq + kg * 8;
#pragma unroll 4
    for (int k = 0; k < kq; k += 32) {
        typedef __attribute__((address_space(1))) const bf16x8 gfrag_t;
        const bf16x8 a = *(gfrag_t*)(ap + k);
#pragma unroll
        for (int cb = 0; cb < 4; ++cb) {
            const bf16x8 bb = *(gfrag_t*)(bp + (size_t)(cb * 16) * ldb + k);
            acc[cb] = __builtin_amdgcn_mfma_f32_16x16x32_bf16(a, bb, acc[cb], 0, 0, 0);
        }
    }
    float* red = (float*)lds;
    __syncthreads();
#pragma unroll
    for (int cb = 0; cb < 4; ++cb)
#pragma unroll
        for (int j = 0; j < 4; ++j) red[((w * 4 + cb) * 4 + j) * 64 + lane] = acc[cb][j];
    __syncthreads();
#pragma unroll
    for (int j = 0; j < 4; ++j) v[j] = (red[((0 * 4 + w) * 4 + j) * 64 + lane] + red[((1 * 4 + w) * 4 + j) * 64 + lane]) + (red[((2 * 4 + w) * 4 + j) * 64 + lane] + red[((3 * 4 + w) * 4 + j) * 64 + lane]);
}
DEVI void mini_rinv(const int TID, float* rinv, const float* part, int stride, int n, float div, int m0) {
    __syncthreads();
    if (TID < 16) { float s = 0.f; for (int j = 0; j < n; ++j) s += part[(size_t)(m0 + TID) * stride + j]; rinv[TID] = rsqrtf(s / div + EPS); }
    __syncthreads();
}
DEVI void mini_rowsum(const int TID, float (&sq)[4], char* lds) {
    const int lane = TID & 63, w = TID >> 6;
#pragma unroll
    for (int j = 0; j < 4; ++j) { float x = sq[j]; x += __shfl_xor(x, 1); x += __shfl_xor(x, 2); x += __shfl_xor(x, 4); x += __shfl_xor(x, 8); sq[j] = x; }
    float* red = (float*)lds + 4096;
    __syncthreads();
    if ((lane & 15) == 0) {
#pragma unroll
        for (int j = 0; j < 4; ++j) red[w * 16 + (lane >> 4) * 4 + j] = sq[j];
    }
    __syncthreads();
#pragma unroll
    for (int j = 0; j < 4; ++j) { const int r = (lane >> 4) * 4 + j; sq[j] = (red[r] + red[16 + r]) + (red[32 + r] + red[48 + r]); }
}


DEVI void store_pair_bf16(gbf16_t* base, unsigned o, unsigned pitch, float a, float b, bool odd) {
    const float x = odd ? a : b;
    const float y = __int_as_float(__builtin_amdgcn_mov_dpp(__float_as_int(x), 0xB1, 0xf, 0xf, true));
    const unsigned pk = odd ? cvt_pk(y, b) : cvt_pk(a, y);
    *(__attribute__((address_space(1))) unsigned*)(base + (odd ? o + pitch - 1 : o)) = pk;
}
DEVI void phase_inproj(const Params& p, char* lds, float* rinv) {
    const bf16_t* hb = (const bf16_t*)(p.ws + OFF_HB);
    const bf16_t* Wt = (const bf16_t*)(p.ws + OFF_W) + W_IN;
    bf16_t* proj = (bf16_t*)(p.ws + OFF_PROJ);
    const float* part = (const float*)(p.ws + OFF_PART);
    float* pcq = (float*)(p.ws + OFF_PCQ); float* pckv = (float*)(p.ws + OFF_PCKV);
    const int lane = p.tid & 63, w = p.tid >> 6, wm = w >> 1, wn = w & 1, hi = lane >> 5, l32 = lane & 31;
    const int ntiles = MT_REAL * 28;
    for (int t = blockIdx.x; t < ntiles; t += gridDim.x) {
        const int mt = t % MT_REAL, nt = t / MT_REAL, m0 = mt * 128, n0 = nt * 128;
        compute_rinv(p.tid, rinv, part, 16, 16, 1024.f, m0);
        f32x16 acc[2][2]; zero_acc<2>(acc);
        gemm_acc<2>(p.tid, hb + (size_t)m0 * DM, DM, Wt + (size_t)n0 * DM, DM, DM, acc, lds);
        const unsigned po = (unsigned)(m0 + wm * 64 + 4 * hi) * PROJ_LD + (unsigned)(n0 + wn * 64 + l32);
#pragma unroll
        for (int mb = 0; mb < 2; ++mb)
#pragma unroll
            for (int rh = 0; rh < 2; ++rh) {
                float sq[8];
#pragma unroll
                for (int k = 0; k < 8; ++k) {
                    const int r = 8 * rh + k;
                    const float ri = rinv[wm * 64 + mb * 32 + crow(r, hi)];
                    const unsigned o = po + (unsigned)(mb * 32 + (r & 3) + 8 * (r >> 2)) * PROJ_LD;
                    const float v0 = acc[mb][0][r] * ri, v1 = acc[mb][1][r] * ri;
                    ((gbf16_t*)proj)[o] = (bf16_t)(cvt_pk(v0, 0.f) & 0xffffu); ((gbf16_t*)proj)[o + 32] = (bf16_t)(cvt_pk(v1, 0.f) & 0xffffu);
                    sq[k] = v0 * v0 + v1 * v1;
                }
                if (nt <= 2) {
#pragma unroll
                    for (int o = 16; o >= 1; o >>= 1) {
                        float tq[8];
#pragma unroll
                        for (int k = 0; k < 8; ++k) tq[k] = __shfl_xor(sq[k], o);
#pragma unroll
                        for (int k = 0; k < 8; ++k) sq[k] += tq[k];
                    }
                    if (l32 == 0) {
#pragma unroll
                        for (int k = 0; k < 8; ++k) { const int m = m0 + wm * 64 + mb * 32 + crow(8 * rh + k, hi); if (nt < 2) pcq[(size_t)m * 4 + nt * 2 + wn] = sq[k]; else pckv[(size_t)m * 2 + wn] = sq[k]; }
                    }
                }
                __builtin_amdgcn_sched_barrier(0);
            }
    }
    for (int pc = blockIdx.x; pc < 4 * 56; pc += gridDim.x) {
        const int b = pc & 3, g = pc >> 2, m0 = meta_row0(b);
        mini_rinv(p.tid, rinv, part, 16, 16, 1024.f, m0);
        float v[4], sq[4];
        mini_gemm(p.tid, hb + (size_t)m0 * DM, DM, Wt + (size_t)g * 64 * DM, DM, DM, v, lds);
        const int n = g * 64 + w * 16 + (lane & 15);
#pragma unroll
        for (int j = 0; j < 4; ++j) {
            const int rr = (lane >> 4) * 4 + j;
            const float val = v[j] * rinv[rr];
            sq[j] = val * val;
            proj[(size_t)(m0 + rr) * PROJ_LD + n] = (bf16_t)(cvt_pk(val, 0.f) & 0xffffu);
        }
        if (g < 6) {
            mini_rowsum(p.tid, sq, lds);
            if (w == 0 && (lane & 15) == 0) {
#pragma unroll
                for (int j = 0; j < 4; ++j) { const int m = m0 + (lane >> 4) * 4 + j; if (g < 4) pcq[(size_t)m * 4 + g] = sq[j]; else pckv[(size_t)m * 2 + g - 4] = sq[j]; }
            }
        }
    }
}

DEVI void phase_upproj(const Params& p, char* lds, float* rinv) {
    const bf16_t* proj = (const bf16_t*)(p.ws + OFF_PROJ);
    const bf16_t* Wb = (const bf16_t*)(p.ws + OFF_W);
    bf16_t* mq = (bf16_t*)(p.ws + OFF_MQ); bf16_t* mk = (bf16_t*)(p.ws + OFF_MK); bf16_t* mv = (bf16_t*)(p.ws + OFF_MV);
    const float* pcq = (const float*)(p.ws + OFF_PCQ); const float* pckv = (const float*)(p.ws + OFF_PCKV);
    const int lane = p.tid & 63, w = p.tid >> 6, wm = w >> 1, wn = w & 1, hi = lane >> 5, l32 = lane & 31;
    const int ntiles = MT_REAL * 14;
    for (int t = blockIdx.x; t < ntiles; t += gridDim.x) {
        const int mt = t % MT_REAL, nt = t / MT_REAL, m0 = mt * 128;
        f32x16 acc[2][2]; zero_acc<2>(acc);
        if (nt < 6) {
            compute_rinv(p.tid, rinv, pcq, 4, 4, 256.f, m0);
            gemm_acc<2>(p.tid, proj + (size_t)m0 * PROJ_LD + C_CQ, PROJ_LD, Wb + W_UQ + (size_t)nt * 128 * 256, 256, 256, acc, lds);
        } else {
            compute_rinv(p.tid, rinv, pckv, 2, 2, 128.f, m0);
            gemm_acc<2>(p.tid, proj + (size_t)m0 * PROJ_LD + C_CKV, PROJ_LD, Wb + W_UKV + (size_t)(nt - 6) * 128 * 128, 128, 128, acc, lds);
        }
#pragma unroll
        for (int mb = 0; mb < 2; ++mb)
#pragma unroll
            for (int r = 0; r < 16; ++r) {
                const int rl = wm * 64 + mb * 32 + crow(r, hi), m = m0 + rl;
                const float ri = rinv[rl];
#pragma unroll
                for (int nb = 0; nb < 2; ++nb) {
                    const int c = nb * 32 + l32;
                    const bf16_t v = (bf16_t)(cvt_pk(acc[mb][nb][r] * ri, 0.f) & 0xffffu);
                    if (nt < 6) mq[(size_t)m * 768 + nt * 128 + wn * 64 + c] = v;
                    else { const int h = nt - 6; if (wn == 0) mk[(size_t)m * 768 + h * 96 + c] = v; else mv[(size_t)m * 512 + h * 64 + c] = v; }
                }
            }
    }
    for (int pc = blockIdx.x; pc < 4 * 28; pc += gridDim.x) {
        const int b = pc & 3, g = pc >> 2, m0 = meta_row0(b);
        float v[4];
        if (g < 12) { mini_rinv(p.tid, rinv, pcq, 4, 4, 256.f, m0); mini_gemm(p.tid, proj + (size_t)m0 * PROJ_LD + C_CQ, PROJ_LD, Wb + W_UQ + (size_t)g * 64 * 256, 256, 256, v, lds); }
        else { mini_rinv(p.tid, rinv, pckv, 2, 2, 128.f, m0); mini_gemm(p.tid, proj + (size_t)m0 * PROJ_LD + C_CKV, PROJ_LD, Wb + W_UKV + (size_t)(g - 12) * 64 * 128, 128, 128, v, lds); }
        const int c = w * 16 + (lane & 15);
#pragma unroll
        for (int j = 0; j < 4; ++j) {
            const int rr = (lane >> 4) * 4 + j, m = m0 + rr;
            const bf16_t o = (bf16_t)(cvt_pk(v[j] * rinv[rr], 0.f) & 0xffffu);
            if (g < 12) mq[(size_t)m * 768 + g * 64 + c] = o;
            else { const int h = (g - 12) >> 1; if (((g - 12) & 1) == 0) mk[(size_t)m * 768 + h * 96 + c] = o; else mv[(size_t)m * 512 + h * 64 + c] = o; }
        }
    }
}

DEVI void sincos_rev(float ang, float& c, float& s) {
    double rev = (double)ang * 0.15915494309189535;
    rev -= floor(rev);
    const float rf = (float)rev;
    s = __builtin_amdgcn_sinf(rf); c = __builtin_amdgcn_cosf(rf);
}
DEVI void ld8(const bf16_t* src, float* x) {
    const u32x4 u = *(const u32x4*)src;
    x[0] = bf2f(u.x & 0xffffu); x[1] = bf2f(u.x >> 16); x[2] = bf2f(u.y & 0xffffu); x[3] = bf2f(u.y >> 16);
    x[4] = bf2f(u.z & 0xffffu); x[5] = bf2f(u.z >> 16); x[6] = bf2f(u.w & 0xffffu); x[7] = bf2f(u.w >> 16);
}
DEVI void st8(bf16_t* dst, const float* x) {
    u32x4 uu = {cvt_pk(x[0], x[1]), cvt_pk(x[2], x[3]), cvt_pk(x[4], x[5]), cvt_pk(x[6], x[7])};
    *(u32x4*)dst = uu;
}
DEVI float sumsq8(const bf16_t* src) {
    float x[8]; ld8(src, x);
    return ((x[0] * x[0] + x[1] * x[1]) + (x[2] * x[2] + x[3] * x[3])) + ((x[4] * x[4] + x[5] * x[5]) + (x[6] * x[6] + x[7] * x[7]));
}
template <int D> DEVI void rope_pair(const bf16_t* pa, const bf16_t* pb, bf16_t* da, bf16_t* db, const float* ga, const float* gb, int i0, float pos, float ri, float os) {
    float a[8], b[8]; ld8(pa, a); ld8(pb, b);
#pragma unroll
    for (int e = 0; e < 8; ++e) {
        const float invf = __builtin_amdgcn_exp2f(-13.287712379549449f * (2.0f * (float)(i0 + e) / (float)D));
        float c, s; sincos_rev(pos * invf, c, s);
        const float ya = a[e] * ri * ga[e], yb = b[e] * ri * gb[e];
        a[e] = (ya * c - yb * s) * os; b[e] = (ya * s + yb * c) * os;
    }
    st8(da, a); st8(db, b);
}
DEVI void phase_normrope(const Params& p, int layer, char* lds) {
    float* gl = (float*)lds;
    __syncthreads();
    if (p.tid < 96) { gl[p.tid] = p.mq_g[layer * 96 + p.tid]; gl[96 + p.tid] = p.mk_g[layer * 96 + p.tid]; }
    if (p.tid < 64) { gl[192 + p.tid] = p.dq_g[layer * 64 + p.tid]; gl[256 + p.tid] = p.dk_g[layer * 64 + p.tid]; }
    __syncthreads();
    bf16_t* proj = (bf16_t*)(p.ws + OFF_PROJ);
    bf16_t* mq = (bf16_t*)(p.ws + OFF_MQ); bf16_t* mk = (bf16_t*)(p.ws + OFF_MK);
    const int total = MROWS * 32, nth = gridDim.x * NTHREADS;
    for (int it = blockIdx.x * NTHREADS + p.tid; it < total; it += nth) {
        const int m = it >> 5, j = it & 31;
        const int mi = (m - NREAL) & 127;
        const float pos = (float)(m < NREAL ? NMETA + (m & (SEQ - 1)) : (mi > PADN ? mi - PADN : 0));
        if (m >= NREAL && mi < PADN) continue;
        if (j < 16) {
            const int h = j & 7;
            const bool isq = j < 8;
            bf16_t* dst = (isq ? mq : mk) + (size_t)m * 768 + h * 96;
            const bf16_t* rsrc = isq ? dst + 64 : proj + (size_t)m * PROJ_LD + C_KR;
            const float* g = gl + (isq ? 0 : 96);
            const float os = isq ? 0.10206207261596575f * LOG2E : 1.f;
            float ss = 0.f;
#pragma unroll
            for (int c = 0; c < 8; ++c) ss += sumsq8(dst + c * 8);
#pragma unroll
            for (int c = 0; c < 4; ++c) ss += sumsq8(rsrc + c * 8);
            const float ri = rsqrtf(ss * (1.f / 96.f) + EPS);
#pragma unroll
            for (int c = 0; c < 8; ++c) {
                float x[8]; ld8(dst + c * 8, x);
#pragma unroll
                for (int e = 0; e < 8; ++e) x[e] = x[e] * ri * g[c * 8 + e] * os;
                st8(dst + c * 8, x);
            }
#pragma unroll
            for (int c = 0; c < 2; ++c)
                rope_pair<32>(rsrc + c * 8, rsrc + 16 + c * 8, dst + 64 + c * 8, dst + 80 + c * 8, g + 64 + c * 8, g + 80 + c * 8, c * 8, pos, ri, os);
        } else {
            const int idx = j & 7;
            const bool isq = j < 24;
            bf16_t* dst = proj + (size_t)m * PROJ_LD + (isq ? C_DQ : C_DK) + idx * 64;
            const float* g = gl + (isq ? 192 : 256);
            const float os = isq ? 0.125f * LOG2E : 1.f;
            float ss = 0.f;
#pragma unroll
            for (int c = 0; c < 8; ++c) ss += sumsq8(dst + c * 8);
            const float ri = rsqrtf(ss * (1.f / 64.f) + EPS);
#pragma unroll
            for (int c = 0; c < 4; ++c)
                rope_pair<64>(dst + c * 8, dst + 32 + c * 8, dst + c * 8, dst + 32 + c * 8, g + c * 8, g + 32 + c * 8, c * 8, pos, ri, os);
        }
    }
}

DEVI s16x4 vtr(lds_cptr p) { return __builtin_bit_cast(s16x4, __builtin_amdgcn_ds_read_tr16_b64_v4i16((LAS v4i16_t*)p)); }

template <int DQK, int DV, int MODE>
DEVI void attn_pass(const int TID, const bf16_t* __restrict__ Qp, int ldq, const bf16_t* __restrict__ Kp, int ldk, const bf16_t* __restrict__ Vp, int ldv,
                    int b, int qt, float Mb, f32x16 (&O)[DV / 32], float& lsum, char* lds, volatile int* flags) {
    constexpr int NDS = DQK / 16, NKL = DQK / 32, NVL = DV / 32, NDB = DV / 32, ATT_VOFF = 64 * DQK * 2, ATT_STAGE = ATT_VOFF + 64 * DV * 2;
    const int tid = TID, lane = tid & 63, w = tid >> 6, hi = lane >> 5, l32 = lane & 31;
    const int qrow = 128 * qt + 32 * w + l32, qmax = 128 * qt + 32 * w + 31;
    bf16x8 qf[NDS];
    const int qg = (qt == 0 ? NREAL + b * 128 : b * SEQ + 128 * (qt - 1)) + 32 * w + l32;
#define KROW(kt_) ((kt_) < 2 ? NREAL + b * 128 + 64 * (kt_) : b * SEQ + 64 * (kt_) - 128)
#pragma unroll
    for (int ds = 0; ds < NDS; ++ds) qf[ds] = *(const bf16x8*)(Qp + (size_t)qg * ldq + 16 * ds + 8 * hi);
#pragma unroll
    for (int ds = 0; ds < NDS; ++ds) asm volatile("" : "+v"(qf[ds]));
#pragma unroll
    for (int db = 0; db < NDB; ++db)
#pragma unroll
        for (int r = 0; r < 16; ++r) O[db][r] = 0.f;
    lsum = 0.f;
    float carry = 0.f;
    const int kt_last = 2 * qt + 1, ntile = kt_last;
    const int wu = __builtin_amdgcn_readfirstlane(w);
    const bf16_t* kg = Kp + (size_t)lane * ldk + wu * 8;
    const bf16_t* vg = Vp + (size_t)(tid >> 2) * ldv + (tid & 3) * 8;
    const int vbase = ATT_VOFF + (4 * hi + ((lane & 15) >> 2)) * 64 + ((lane >> 4) & 1) * 32 + (lane & 3) * 8;
    const int kbase = hi * 1024 + l32 * 16;
    const unsigned ldsb = (unsigned)(uintptr_t)lds + wu * 1024;
#define ATT_ISSUE(kt_, stg_) do { const int kr = KROW(kt_); const unsigned sd = (unsigned)__builtin_amdgcn_readfirstlane(ldsb + (stg_) * ATT_STAGE); \
        _Pragma("unroll") for (int i = 0; i < NKL; ++i) glds16(kg + (size_t)kr * ldk + 32 * i, sd + i * 4096); \
        _Pragma("unroll") for (int i = 0; i < NVL; ++i) glds16(vg + (size_t)kr * ldv + 32 * i, sd + ATT_VOFF + i * 4096); } while (0)
    ATT_ISSUE(MODE == 1 ? kt_last : 1, 0);
#pragma unroll 1
    for (int it = 0; it < ntile; ++it) {
        const int kt = MODE == 1 ? kt_last - it : 1 + it;
        const char* st = lds + (it & 1) * ATT_STAGE;
        asm volatile("s_waitcnt vmcnt(0) lgkmcnt(0)\n\ts_barrier" ::: "memory");
        if (MODE == 1 && it > 0) {
            const volatile int* f = flags + ((it - 1) & 1) * 4;
            if (f[0] & f[1] & f[2] & f[3]) break;
        }
        if (it + 1 < ntile) ATT_ISSUE(MODE == 1 ? kt - 1 : kt + 1, (it + 1) & 1);
        int done = 0;
        if (64 * kt <= qmax) {
            bf16x8 pf[4];
            float cb = carry;
            const bool need_mask = (kt >= 2 * qt) || (kt == 1);
#pragma unroll
            for (int kk = 0; kk < 2; ++kk) {
                const int kb = MODE == 1 ? 1 - kk : kk;
                f32x16 S;
#pragma unroll
                for (int r = 0; r < 16; ++r) S[r] = MODE == 0 ? -Mb : 0.f;
                bf16x8 kf[NDS];
#pragma unroll
                for (int ds = 0; ds < NDS; ++ds) kf[ds] = *(const bf16x8*)(st + kbase + ds * 2048 + kb * 512);
                __builtin_amdgcn_sched_barrier(0);
#pragma unroll
                for (int ds = 0; ds < NDS; ++ds) S = MFMA(kf[ds], qf[ds], S);
                if (MODE == 0) {
#pragma unroll
                    for (int r = 0; r < 16; ++r) {
                        float pv = __builtin_amdgcn_exp2f(S[r]);
                        if (need_mask) { const int key = 64 * kt + 32 * kb + crow(r, hi); pv = (key <= qrow && key >= PADN) ? pv : 0.f; }
                        S[r] = pv; lsum += pv;
                    }
                } else {
                    float lk[16], T[4], U[4];
#pragma unroll
                    for (int r = 0; r < 16; ++r) {
                        const int key = 64 * kt + 32 * kb + crow(r, hi);
                        const bool valid = (key < qrow) && (key >= PADN);
                        const float z = S[r];
                        const float sp = fmaxf(z, 0.f) + __builtin_amdgcn_logf(1.f + __builtin_amdgcn_exp2f(-fabsf(z)));
                        lk[r] = valid ? -sp : 0.f;
                        S[r] = valid ? z - sp : -INFINITY;
                    }
#pragma unroll
                    for (int g = 0; g < 4; ++g) { T[g] = (lk[4 * g] + lk[4 * g + 1]) + (lk[4 * g + 2] + lk[4 * g + 3]); U[g] = __shfl_xor(T[g], 32); }
                    float acc_hi = cb;
#pragma unroll
                    for (int g = 3; g >= 0; --g) {
                        float run = acc_hi + (hi == 0 ? U[g] : 0.f);
#pragma unroll
                        for (int i = 3; i >= 0; --i) { const int r = 4 * g + i; S[r] = __builtin_amdgcn_exp2f(S[r] + run); run += lk[r]; }
                        acc_hi += T[g] + U[g];
                    }
                    cb = acc_hi;
                }
#pragma unroll
                for (int c = 0; c < 2; ++c) {
                    u32x4 uu = {cvt_pk(S[8 * c + 0], S[8 * c + 1]), cvt_pk(S[8 * c + 2], S[8 * c + 3]), cvt_pk(S[8 * c + 4], S[8 * c + 5]), cvt_pk(S[8 * c + 6], S[8 * c + 7])};
                    pf[2 * kb + c] = __builtin_bit_cast(bf16x8, uu);
                }
                if (DV == 128) __builtin_amdgcn_sched_barrier(0);
            }
            carry = cb;
            {
                constexpr int NG = 2 * NDB;
                s16x4 vb[2][4];
#define ATT_VRD(gi_, buf_) do { const int db_ = (gi_) >> 1, k2_ = (gi_) & 1; \
                    _Pragma("unroll") for (int kc = 0; kc < 2; ++kc) { vb[buf_][2 * kc] = vtr((lds_cptr)(st + vbase + db_ * 4096 + (2 * k2_ + kc) * 1024)); \
                        vb[buf_][2 * kc + 1] = vtr((lds_cptr)(st + vbase + db_ * 4096 + (2 * k2_ + kc) * 1024 + 512)); } } while (0)
                ATT_VRD(0, 0);
                __builtin_amdgcn_sched_barrier(0);
#pragma unroll
                for (int gi = 0; gi < NG; ++gi) {
                    if (gi + 1 < NG) ATT_VRD(gi + 1, (gi + 1) & 1);
#pragma unroll
                    for (int kc = 0; kc < 2; ++kc) {
                        const s16x4 lo = vb[gi & 1][2 * kc], h4 = vb[gi & 1][2 * kc + 1];
                        const bf16x8 vt = {lo[0], lo[1], lo[2], lo[3], h4[0], h4[1], h4[2], h4[3]};
                        O[gi >> 1] = MFMA(vt, pf[2 * (gi & 1) + kc], O[gi >> 1]);
                    }
                    if (gi + 1 < NG) __builtin_amdgcn_sched_group_barrier(0x100, 4, 0);
                    __builtin_amdgcn_sched_group_barrier(0x008, 2, 0);
                    __builtin_amdgcn_sched_barrier(0);
                }
#undef ATT_VRD
            }
            if (MODE == 1) done = __all(carry < -152.f) ? 1 : 0;
        }
        if (MODE == 1 && lane == 0) flags[(it & 1) * 4 + w] = done;
    }
    asm volatile("s_waitcnt vmcnt(0) lgkmcnt(0)\n\ts_barrier" ::: "memory");
#undef KROW
#undef ATT_ISSUE
}

template <int NDB> DEVI void store_o(bf16_t* Op, int ldo, int qrow, int hi, const f32x16 (&O)[NDB], float scale) {
#pragma unroll
    for (int db = 0; db < NDB; ++db)
#pragma unroll
        for (int g = 0; g < 4; ++g) {
            u32x2 v; v.x = cvt_pk(O[db][4 * g] * scale, O[db][4 * g + 1] * scale); v.y = cvt_pk(O[db][4 * g + 2] * scale, O[db][4 * g + 3] * scale);
            *(u32x2*)(Op + (size_t)qrow * ldo + 32 * db + 8 * g + 4 * hi) = v;
        }
}

DEVI void phase_attn(const Params& p, int layer, char* lds, int* sh) {
    bf16_t* proj = (bf16_t*)(p.ws + OFF_PROJ);
    bf16_t* mq = (bf16_t*)(p.ws + OFF_MQ); bf16_t* mk = (bf16_t*)(p.ws + OFF_MK); bf16_t* mv = (bf16_t*)(p.ws + OFF_MV);
    unsigned* ctr = (unsigned*)(p.ws + OFF_BAR) + XB_QUEUE(layer + 2 * p.pad2);
    const float* cs = (const float*)(p.ws + OFF_CONST) + layer * 16;
    const float Mb_mla = cs[0], Mb_diff = cs[1], lam = cs[2];
    const int tid = p.tid, lane = tid & 63, w = tid >> 6, hi = lane >> 5, l32 = lane & 31;
    volatile int* flags = sh + 8;
    const int NUNITS = NQT * 80;
    for (;;) {
        __syncthreads();
        if (tid == 0) sh[0] = (int)atomicAdd(ctr, 1u);
        __syncthreads();
        const int u = sh[0];
        if (u >= NUNITS) break;
        const int qt = 32 - u / 80, v = u % 80;
#ifndef ATT_ONLY
#define ATT_ONLY -1
#endif
        if (v < 16 && (ATT_ONLY < 0 || ATT_ONLY == 0)) {
            int tl = p.tid; asm volatile("" : "+v"(tl));
            const int b = v >> 2, h = v & 3;
            const int qrow = (qt == 0 ? NREAL + b * 128 : b * SEQ + 128 * (qt - 1)) + 32 * w + l32;
            bf16_t* base = proj;
            bf16_t* Q1 = base + C_DQ + h * 128; const bf16_t* K1 = base + C_DK + h * 128; const bf16_t* V = base + C_DV + h * 128;
            f32x16 O[4]; float l1, l2;
            attn_pass<64, 128, 0>(tl, Q1, PROJ_LD, K1, PROJ_LD, V, PROJ_LD, b, qt, Mb_diff, O, l1, lds, flags);
            l1 += __shfl_xor(l1, 32);
            const float i1 = l1 > 0.f ? 1.f / l1 : 0.f;
            unsigned o1p[1][8];
            u32x4* stash = (u32x4*)(lds + 49152) + tid;
#pragma unroll
            for (int db = 0; db < 1; ++db)
#pragma unroll
                for (int r = 0; r < 8; ++r) o1p[db][r] = cvt_pk(O[db][2 * r] * i1, O[db][2 * r + 1] * i1);
#pragma unroll
            for (int db = 1; db < 4; ++db)
#pragma unroll
                for (int c = 0; c < 2; ++c) {
                    u32x4 uu = {cvt_pk(O[db][8 * c] * i1, O[db][8 * c + 1] * i1), cvt_pk(O[db][8 * c + 2] * i1, O[db][8 * c + 3] * i1),
                                cvt_pk(O[db][8 * c + 4] * i1, O[db][8 * c + 5] * i1), cvt_pk(O[db][8 * c + 6] * i1, O[db][8 * c + 7] * i1)};
                    stash[((db - 1) * 2 + c) * 256] = uu;
                }
            attn_pass<64, 128, 0>(tl, Q1 + 64, PROJ_LD, K1 + 64, PROJ_LD, V, PROJ_LD, b, qt, Mb_diff, O, l2, lds, flags);
            l2 += __shfl_xor(l2, 32);
            const float i2 = l2 > 0.f ? lam / l2 : 0.f;
            float ss = 0.f;
#pragma unroll
            for (int db = 0; db < 1; ++db)
#pragma unroll
                for (int r = 0; r < 8; ++r) {
                    const float a = bf2f(o1p[db][r] & 0xffffu) - O[db][2 * r] * i2, c = bf2f(o1p[db][r] >> 16) - O[db][2 * r + 1] * i2;
                    O[db][2 * r] = a; O[db][2 * r + 1] = c; ss += a * a + c * c;
                }
#pragma unroll
            for (int db = 1; db < 4; ++db)
#pragma unroll
                for (int c = 0; c < 2; ++c) {
                    const u32x4 uu = stash[((db - 1) * 2 + c) * 256];
#pragma unroll
                    for (int e = 0; e < 4; ++e) {
                        const int r = 8 * c + 2 * e;
                        const float a = bf2f(uu[e] & 0xffffu) - O[db][r] * i2, cc = bf2f(uu[e] >> 16) - O[db][r + 1] * i2;
                        O[db][r] = a; O[db][r + 1] = cc; ss += a * a + cc * cc;
                    }
                }
            ss += __shfl_xor(ss, 32);
            const float ri = rsqrtf(ss * (1.f / 128.f) + EPS);
            if (!p.pad2) store_o<4>(Q1, PROJ_LD, qrow, hi, O, ri);
        } else if (v >= 16 && v < 48 && (ATT_ONLY < 0 || ATT_ONLY == 1)) {
            int tl = p.tid; asm volatile("" : "+v"(tl));
            const int vv = v - 16, b = vv >> 3, h = vv & 7;
            const int qrow = (qt == 0 ? NREAL + b * 128 : b * SEQ + 128 * (qt - 1)) + 32 * w + l32;
            bf16_t* Q = mq + h * 96;
            const bf16_t* K = mk + h * 96;
            const bf16_t* V = mv + h * 64;
            f32x16 O[2]; float l;
            attn_pass<96, 64, 0>(tl, Q, 768, K, 768, V, 512, b, qt, Mb_mla, O, l, lds, flags);
            l += __shfl_xor(l, 32);
            if (!p.pad2) store_o<2>(Q, 768, qrow, hi, O, l > 0.f ? 1.f / l : 0.f);
        } else if (v >= 48 && (ATT_ONLY < 0 || ATT_ONLY == 2)) {
            int tl = p.tid; asm volatile("" : "+v"(tl));
            const int vv = v - 48, b = vv >> 3, h = vv & 7;
            const int qrow = (qt == 0 ? NREAL + b * 128 : b * SEQ + 128 * (qt - 1)) + 32 * w + l32;
            bf16_t* base = proj;
            f32x16 O[2]; float l;
            attn_pass<64, 64, 1>(tl, base + C_SBQ + h * 64, PROJ_LD, base + C_SBK + h * 64, PROJ_LD, base + C_SBV + h * 64, PROJ_LD, b, qt, 0.f, O, l, lds, flags);
            if (!p.pad2) store_o<2>(base + C_SBQ + h * 64, PROJ_LD, qrow, hi, O, 1.f);
        }
    }
}

DEVI bf16_t* gate_ptr(const Params& p, int br, int m) {
    if (br == 0) return (bf16_t*)(p.ws + OFF_MERGED) + (size_t)m * DM;
    return (bf16_t*)(p.ws + OFF_PROJ) + (size_t)m * PROJ_LD + (br == 1 ? C_SBK : C_DK);
}
DEVI void phase_gates(const Params& p, int layer, char* lds, float* rinv) {
    const bf16_t* hb = (const bf16_t*)(p.ws + OFF_HB);
    const bf16_t* Wt = (const bf16_t*)(p.ws + OFF_W) + W_GATE;
    const float* part = (const float*)(p.ws + OFF_PART);
    const float* gb = p.gate_b + layer * 3072;
    const int lane = p.tid & 63, w = p.tid >> 6, wm = w >> 1, wn = w & 1, hi = lane >> 5, l32 = lane & 31;
    const int ntiles = MT_REAL * 12;
    for (int t = blockIdx.x; t < ntiles; t += gridDim.x) {
        const int mt = t % MT_REAL, nt = t / MT_REAL, m0 = mt * 128, n0 = nt * 256, br = nt >> 2;
        compute_rinv(p.tid, rinv, part, 16, 16, 1024.f, m0);
        f32x16 acc[2][4]; zero_acc<4>(acc);
        gemm_acc<4, 64, 1>(p.tid, hb + (size_t)m0 * DM, DM, Wt + (size_t)n0 * DM, DM, DM, acc, lds);
        float bias[4];
#pragma unroll
        for (int nb = 0; nb < 4; ++nb) bias[nb] = gb[n0 + wn * 128 + nb * 32 + l32];
        bf16_t* gbase = gate_ptr(p, br, 0); const unsigned gpitch = br == 0 ? DM : PROJ_LD;
        const unsigned go = (unsigned)(m0 + wm * 64 + 4 * hi) * gpitch + (unsigned)((n0 & 1023) + wn * 128 + l32);
        const bool odd = lane & 1;
#pragma unroll
        for (int mb = 0; mb < 2; ++mb)
#pragma unroll
            for (int r = 0; r < 16; r += 2) {
                const int rl = wm * 64 + mb * 32 + crow(r, hi);
                const float ri0 = rinv[rl], ri1 = rinv[rl + 1];
                const unsigned o = go + (unsigned)(mb * 32 + (r & 3) + 8 * (r >> 2)) * gpitch;
#pragma unroll
                for (int nb = 0; nb < 4; ++nb) {
                    const float z0 = acc[mb][nb][r] * ri0 + bias[nb], z1 = acc[mb][nb][r + 1] * ri1 + bias[nb];
                    store_pair_bf16((gbf16_t*)gbase, o + nb * 32, gpitch, 1.f / (1.f + __builtin_amdgcn_exp2f(-z0 * LOG2E)), 1.f / (1.f + __builtin_amdgcn_exp2f(-z1 * LOG2E)), odd);
                }
                if ((r & 3) == 2) __builtin_amdgcn_sched_barrier(0);
            }
    }
    for (int pc = blockIdx.x; pc < 4 * 48; pc += gridDim.x) {
        const int b = pc & 3, g = pc >> 2, m0 = meta_row0(b), br = g >> 4;
        mini_rinv(p.tid, rinv, part, 16, 16, 1024.f, m0);
        float v[4];
        mini_gemm(p.tid, hb + (size_t)m0 * DM, DM, Wt + (size_t)g * 64 * DM, DM, DM, v, lds);
        const int n = g * 64 + w * 16 + (lane & 15);
        const float bias = gb[n];
#pragma unroll
        for (int j = 0; j < 4; ++j) {
            const int rr = (lane >> 4) * 4 + j;
            const float z = v[j] * rinv[rr] + bias;
            gate_ptr(p, br, m0 + rr)[n & 1023] = (bf16_t)(cvt_pk(1.f / (1.f + __builtin_amdgcn_exp2f(-z * LOG2E)), 0.f) & 0xffffu);
        }
    }
}

DEVI void phase_merge(const Params& p, int layer, char* lds, float* rinv) {
    const bf16_t* Wb = (const bf16_t*)(p.ws + OFF_W);
    const bf16_t* proj = (const bf16_t*)(p.ws + OFF_PROJ);
    const bf16_t* mq = (const bf16_t*)(p.ws + OFF_MQ);
    bf16_t* merged = (bf16_t*)(p.ws + OFF_MERGED);
    const int lane = p.tid & 63, w = p.tid >> 6, wm = w >> 1, wn = w & 1, hi = lane >> 5, l32 = lane & 31;
    const int ntiles = MT_REAL * 8;
    for (int t = blockIdx.x; t < ntiles; t += gridDim.x) {
        const int mt = t % MT_REAL, nt = t / MT_REAL, m0 = mt * 128, n0 = nt * 128;
        f32x16 mg[2][2]; zero_acc<2>(mg);
#pragma unroll 1
        for (int br = 0; br < 3; ++br) {
            const bf16_t* A; int lda, K; const bf16_t* W;
            if (br == 0) { A = mq + (size_t)m0 * 768; lda = 768; K = 768; W = Wb + W_BA + (size_t)n0 * 768; }
            else if (br == 1) { A = proj + (size_t)m0 * PROJ_LD + C_SBQ; lda = PROJ_LD; K = 512; W = Wb + W_BB + (size_t)n0 * 512; }
            else { A = proj + (size_t)m0 * PROJ_LD + C_DQ; lda = PROJ_LD; K = 512; W = Wb + W_BC + (size_t)n0 * 512; }
            f32x16 acc[2][2]; zero_acc<2>(acc);
            gemm_acc<2>(p.tid, A, lda, W, K, K, acc, lds);
            const bf16_t* gbase = gate_ptr(p, br, 0); const unsigned gpitch = br == 0 ? DM : PROJ_LD;
            const unsigned go = (unsigned)(m0 + wm * 64 + 4 * hi) * gpitch + (unsigned)(n0 + wn * 64 + l32);
#pragma unroll
            for (int mb = 0; mb < 2; ++mb)
#pragma unroll
                for (int r = 0; r < 16; ++r) {
                    const unsigned o = go + (unsigned)(mb * 32 + (r & 3) + 8 * (r >> 2)) * gpitch;
#pragma unroll
                    for (int nb = 0; nb < 2; ++nb) mg[mb][nb][r] += bf2f(((const gbf16_t*)gbase)[o + nb * 32]) * acc[mb][nb][r];
                    if ((r & 7) == 7) __builtin_amdgcn_sched_barrier(0);
                }
        }
#pragma unroll
        for (int mb = 0; mb < 2; ++mb)
#pragma unroll
            for (int r = 0; r < 16; ++r) {
                const int m = m0 + wm * 64 + mb * 32 + crow(r, hi);
#pragma unroll
                for (int nb = 0; nb < 2; ++nb) merged[(size_t)m * DM + n0 + wn * 64 + nb * 32 + l32] = (bf16_t)(cvt_pk(mg[mb][nb][r], 0.f) & 0xffffu);
            }
    }
    for (int pc = blockIdx.x; pc < 4 * 16; pc += gridDim.x) {
        const int b = pc & 3, gq = pc >> 2, m0 = meta_row0(b), n0 = gq * 64;
        const int n = n0 + w * 16 + (lane & 15);
        float mg[4] = {0.f, 0.f, 0.f, 0.f};
#pragma unroll 1
        for (int br = 0; br < 3; ++br) {
            const bf16_t* A; int lda, K; const bf16_t* W;
            if (br == 0) { A = mq + (size_t)m0 * 768; lda = 768; K = 768; W = Wb + W_BA + (size_t)n0 * 768; }
            else if (br == 1) { A = proj + (size_t)m0 * PROJ_LD + C_SBQ; lda = PROJ_LD; K = 512; W = Wb + W_BB + (size_t)n0 * 512; }
            else { A = proj + (size_t)m0 * PROJ_LD + C_DQ; lda = PROJ_LD; K = 512; W = Wb + W_BC + (size_t)n0 * 512; }
            float v[4];
            mini_gemm(p.tid, A, lda, W, K, K, v, lds);
#pragma unroll
            for (int j = 0; j < 4; ++j) mg[j] += bf2f(gate_ptr(p, br, m0 + (lane >> 4) * 4 + j)[n]) * v[j];
        }
#pragma unroll
        for (int j = 0; j < 4; ++j) merged[(size_t)(m0 + (lane >> 4) * 4 + j) * DM + n] = (bf16_t)(cvt_pk(mg[j], 0.f) & 0xffffu);
    }
}

DEVI void phase_resid(const Params& p, const bf16_t* A, int K, const bf16_t* Wt, char* lds) {
    bf16_t* hb = (bf16_t*)(p.ws + OFF_HB);
    float* part = (float*)(p.ws + OFF_PART);
    const int lane = p.tid & 63, w = p.tid >> 6, wm = w >> 1, wn = w & 1, hi = lane >> 5, l32 = lane & 31;
    const int ntiles = MT_REAL * 4;
    for (int t = blockIdx.x; t < ntiles; t += gridDim.x) {
        const int mt = t % MT_REAL, nt = t / MT_REAL, m0 = mt * 128, n0 = nt * 256;
        f32x16 acc[2][4]; zero_acc<4>(acc);
        gemm_acc<4, 64, 1>(p.tid, A + (size_t)m0 * K, K, Wt + (size_t)n0 * K, K, K, acc, lds);
        gf32_t* outg = (gf32_t*)p.out; gbf16_t* hbg = (gbf16_t*)hb;
        const unsigned ho = (unsigned)(m0 + wm * 64 + 4 * hi) * DM + (unsigned)(n0 + wn * 128 + l32);
#pragma unroll
        for (int mb = 0; mb < 2; ++mb)
#pragma unroll
            for (int rg = 0; rg < 4; ++rg) {
                float hv[4][4];
#pragma unroll
                for (int j = 0; j < 4; ++j)
#pragma unroll
                    for (int nb = 0; nb < 4; ++nb) hv[j][nb] = outg[ho + (unsigned)(mb * 32 + 8 * rg + j) * DM + nb * 32];
                __builtin_amdgcn_sched_barrier(0);
                float sq[8];
#pragma unroll
                for (int j = 0; j < 4; ++j)
#pragma unroll
                    for (int nb = 0; nb < 4; ++nb) {
                        const float h = hv[j][nb] + acc[mb][nb][4 * rg + j];
                        const unsigned o = ho + (unsigned)(mb * 32 + 8 * rg + j) * DM + nb * 32;
                        if (!p.pad2) { outg[o] = h; hbg[o] = (bf16_t)(cvt_pk(h, 0.f) & 0xffffu); }
                        if ((nb & 1) == 0) sq[2 * j + (nb >> 1)] = h * h; else sq[2 * j + (nb >> 1)] += h * h;
                    }
#pragma unroll
                for (int o = 16; o >= 1; o >>= 1) {
                    float tq[8];
#pragma unroll
                    for (int k = 0; k < 8; ++k) tq[k] = __shfl_xor(sq[k], o);
#pragma unroll
                    for (int k = 0; k < 8; ++k) sq[k] += tq[k];
                }
                if (l32 == 0 && !p.pad2) {
#pragma unroll
                    for (int j = 0; j < 4; ++j) {
                        float* pp = part + (size_t)(m0 + wm * 64 + mb * 32 + 8 * rg + 4 * hi + j) * 16 + nt * 4 + wn * 2;
                        pp[0] = sq[2 * j]; pp[1] = sq[2 * j + 1];
                    }
                }
                __builtin_amdgcn_sched_barrier(0);
            }
    }
    for (int pc = blockIdx.x; pc < 4 * 16; pc += gridDim.x) {
        const int b = pc & 3, g = pc >> 2, m0 = meta_row0(b);
        float v[4], sq[4];
        mini_gemm(p.tid, A + (size_t)m0 * K, K, Wt + (size_t)g * 64 * K, K, K, v, lds);
        const int n = g * 64 + w * 16 + (lane & 15);
#pragma unroll
        for (int j = 0; j < 4; ++j) {
            const int m = m0 + (lane >> 4) * 4 + j;
            float* hp = rowptr(p, m);
            const float h = hp[n] + v[j];
            if (!p.pad2) { hp[n] = h; hb[(size_t)m * DM + n] = (bf16_t)(cvt_pk(h, 0.f) & 0xffffu); }
            sq[j] = h * h;
        }
        mini_rowsum(p.tid, sq, lds);
        if (w == 0 && (lane & 15) == 0 && !p.pad2) {
#pragma unroll
            for (int j = 0; j < 4; ++j) part[(size_t)(m0 + (lane >> 4) * 4 + j) * 16 + g] = sq[j];
        }
    }
}

DEVI void phase_ff1(const Params& p, char* lds, float* rinv) {
    const bf16_t* hb = (const bf16_t*)(p.ws + OFF_HB);
    const bf16_t* Wt = (const bf16_t*)(p.ws + OFF_W) + W_FF1;
    bf16_t* ff = (bf16_t*)(p.ws + OFF_FF);
    const float* part = (const float*)(p.ws + OFF_PART);
    const int lane = p.tid & 63, w = p.tid >> 6, wm = w >> 1, wn = w & 1, hi = lane >> 5, l32 = lane & 31;
    const int ntiles = MT_REAL * 16;
    for (int t = blockIdx.x; t < ntiles; t += gridDim.x) {
        const int mt = t % MT_REAL, nt = t / MT_REAL, m0 = mt * 128, n0 = nt * 256;
        compute_rinv(p.tid, rinv, part, 16, 16, 1024.f, m0);
        f32x16 acc[2][4]; zero_acc<4>(acc);
        gemm_acc<4, 64, 1>(p.tid, hb + (size_t)m0 * DM, DM, Wt + (size_t)n0 * DM, DM, DM, acc, lds);
        const unsigned fo = (unsigned)(m0 + wm * 64 + 4 * hi) * 4096u + (unsigned)(n0 + wn * 128 + l32);
        const bool odd = lane & 1;
#pragma unroll
        for (int mb = 0; mb < 2; ++mb)
#pragma unroll
            for (int r = 0; r < 16; r += 2) {
                const int rl = wm * 64 + mb * 32 + crow(r, hi);
                const float ri0 = rinv[rl], ri1 = rinv[rl + 1];
                const unsigned o = fo + (unsigned)(mb * 32 + (r & 3) + 8 * (r >> 2)) * 4096u;
#pragma unroll
                for (int nb = 0; nb < 4; ++nb) {
                    const float v0 = fmaxf(acc[mb][nb][r] * ri0, 0.f), v1 = fmaxf(acc[mb][nb][r + 1] * ri1, 0.f);
                    store_pair_bf16((gbf16_t*)ff, o + nb * 32, 4096u, v0 * v0, v1 * v1, odd);
                }
                if ((r & 3) == 2) __builtin_amdgcn_sched_barrier(0);
            }
    }
    for (int pc = blockIdx.x; pc < 4 * 64; pc += gridDim.x) {
        const int b = pc & 3, g = pc >> 2, m0 = meta_row0(b);
        mini_rinv(p.tid, rinv, part, 16, 16, 1024.f, m0);
        float v[4];
        mini_gemm(p.tid, hb + (size_t)m0 * DM, DM, Wt + (size_t)g * 64 * DM, DM, DM, v, lds);
        const int n = g * 64 + w * 16 + (lane & 15);
#pragma unroll
        for (int j = 0; j < 4; ++j) {
            const int rr = (lane >> 4) * 4 + j;
            const float x = fmaxf(v[j] * rinv[rr], 0.f);
            ff[(size_t)(m0 + rr) * 4096 + n] = (bf16_t)(cvt_pk(x * x, 0.f) & 0xffffu);
        }
    }
}

__global__ void __launch_bounds__(NTHREADS, 2) hybrid_fwd(Params p) {
    __shared__ __attribute__((aligned(16))) char smem[73728];
    __shared__ __attribute__((aligned(16))) float rinv[128];
    __shared__ __attribute__((aligned(16))) int sh[16];
    __shared__ uint4 xb_words;
    if (p.never) cg::this_grid().sync();
    if (threadIdx.x == 0) xb_words = make_uint4(0u, 0u, 0u, 0u);
    __syncthreads();
    XcdBarrier xb;
    if (p.use_bar) xb = xcd_barrier_post((unsigned*)(p.ws + OFF_BAR), (volatile LAS unsigned*)&xb_words);
    for (int ph = p.ph_lo; ph < p.ph_hi; ++ph) {
#ifndef PROBE_REP
#define PROBE_REP -1
#endif
#ifndef ONLYP
#define ONLYP -1
#endif
        constexpr int PER = PROBE_REP >= 0 ? 11 : 10;
        const int layer = ph / PER, si = ph % PER;
        const int s = (PROBE_REP >= 0 && si > PROBE_REP) ? si - 1 : si;
        Params q = p;
        q.tid = threadIdx.x;
        q.pad2 = (PROBE_REP >= 0 && si == PROBE_REP && (s == 4 || s == 7 || s == 9)) ? 1 : 0;
        asm volatile("" : "+s"(q.ws), "+s"(q.out), "+v"(q.tid) :: "memory");
        const bf16_t* Wb = (const bf16_t*)(q.ws + OFF_W);
        switch (s) {
            case 0: if (ONLYP < 0 || ONLYP == 0) phase_prep(q, layer, smem); break;
            case 1: if (ONLYP < 0 || ONLYP == 1) phase_inproj(q, smem, rinv); break;
            case 2: if (ONLYP < 0 || ONLYP == 2) phase_upproj(q, smem, rinv); break;
            case 3: if (ONLYP < 0 || ONLYP == 3) phase_normrope(q, layer, smem); break;
            case 4: if (ONLYP < 0 || ONLYP == 4) phase_attn(q, layer, smem, sh); break;
            case 5: if (ONLYP < 0 || ONLYP == 5) phase_gates(q, layer, smem, rinv); break;
            case 6: if (ONLYP < 0 || ONLYP == 6) phase_merge(q, layer, smem, rinv); break;
            case 7: if (ONLYP < 0 || ONLYP == 7) phase_resid(q, (const bf16_t*)(q.ws + OFF_MERGED), 1024, Wb + W_OUT, smem); break;
            case 8: if (ONLYP < 0 || ONLYP == 8) phase_ff1(q, smem, rinv); break;
            default: if (ONLYP < 0 || ONLYP == 9) phase_resid(q, (const bf16_t*)(q.ws + OFF_FF), 4096, Wb + W_FF2, smem); break;
        }
        if (ph + 1 < p.ph_hi && p.use_bar) xcd_barrier(xb);
    }
}

#ifndef ONE_LAUNCH
#define ONE_LAUNCH 1
#endif

extern "C" void kernel_launch(void* const* d_in, const int* in_sizes, int n_in, void* d_out, int out_size, void* d_ws, size_t ws_size, hipStream_t stream) {
    if (ws_size < WS_NEED) { fprintf(stderr, "workspace too small: %zu < %zu\n", ws_size, (size_t)WS_NEED); return; }
    Params p{};
    const float** f = (const float**)&p;
    for (int i = 0; i < 20; ++i) f[i] = (const float*)d_in[i];
    p.out = (float*)d_out; p.ws = (char*)d_ws; p.never = 0;
    hipMemsetAsync(d_ws, 0, ZERO_BYTES, stream);
    const int grid = 512;
#if ONE_LAUNCH
    p.ph_lo = 0; p.ph_hi = (PROBE_REP >= 0) ? 22 : 20; p.use_bar = 1;
    void* args[] = {&p};
    hipError_t e = hipLaunchCooperativeKernel((void*)hybrid_fwd, dim3(grid), dim3(NTHREADS), args, 0, stream);
    if (e != hipSuccess) fprintf(stderr, "cooperative launch failed: %s\n", hipGetErrorString(e));
#else
    for (int ph = 0; ph < 20; ++ph) {
        p.ph_lo = ph; p.ph_hi = ph + 1; p.use_bar = 0;
        hybrid_fwd<<<grid, NTHREADS, 0, stream>>>(p);
    }
#endif
}
```

```cpp
#include <hip/hip_runtime.h>
#include <hip/hip_cooperative_groups.h>
#include <stdint.h>
#include <stdio.h>
namespace cg = cooperative_groups;

typedef unsigned short bf16_t;
typedef short bf16x8 __attribute__((ext_vector_type(8)));
typedef short s16x4 __attribute__((ext_vector_type(4)));
typedef float f32x16 __attribute__((ext_vector_type(16)));
typedef unsigned u32x2 __attribute__((ext_vector_type(2)));
typedef unsigned u32x4 __attribute__((ext_vector_type(4)));
typedef float f32x4 __attribute__((ext_vector_type(4)));
#define DEVI __device__ __forceinline__
#define LAS __attribute__((address_space(3)))
typedef LAS const char* lds_cptr;
typedef __attribute__((address_space(1))) unsigned short gbf16_t;
typedef __attribute__((address_space(1))) float gf32_t;
typedef short v4i16_t __attribute__((ext_vector_type(4)));

constexpr int DM = 1024, NB_ = 4, SEQ = 4096, PLEN = 4224, MROWS = NB_ * PLEN, NQT = 33, PADN = 112, NMETA = 16;
constexpr int IN_COLS = 6560, NMAIN = 3488, PROJ_LD = 3584;
constexpr int C_CQ = 0, C_CKV = 256, C_KR = 384, C_SBQ = 416, C_SBK = 928, C_SBV = 1440, C_DQ = 1952, C_DK = 2464, C_DV = 2976;
constexpr float EPS = 1e-6f, LOG2E = 1.4426950408889634f;
constexpr int NTHREADS = 256;
constexpr int NREAL = NB_ * SEQ, MT_REAL = NREAL / 128;

constexpr size_t OFF_BAR = 0;
constexpr size_t ZERO_BYTES = 32768;
constexpr size_t OFF_CONST = 32768;
constexpr size_t OFF_META = 65536;
constexpr size_t OFF_PART = OFF_META + 64 * 1024 * 4;
constexpr size_t OFF_PCQ = OFF_PART + (size_t)MROWS * 16 * 4;
constexpr size_t OFF_PCKV = OFF_PCQ + (size_t)MROWS * 4 * 4;
constexpr size_t OFF_W = 2u << 20;
constexpr size_t W_IN = 0, W_GATE = W_IN + (size_t)PROJ_LD * 1024, W_UQ = W_GATE + (size_t)3072 * 1024, W_UKV = W_UQ + 768 * 256,
                 W_BA = W_UKV + 1024 * 128, W_BB = W_BA + 1024 * 768, W_BC = W_BB + 1024 * 512, W_OUT = W_BC + 1024 * 512,
                 W_FF1 = W_OUT + 1024 * 1024, W_FF2 = W_FF1 + (size_t)4096 * 1024, W_END = W_FF2 + (size_t)4096 * 1024;
constexpr size_t OFF_HB = OFF_W + W_END * 2;
constexpr size_t OFF_PROJ = OFF_HB + (size_t)MROWS * 1024 * 2;
constexpr size_t OFF_MQ = OFF_PROJ + (size_t)MROWS * PROJ_LD * 2;
constexpr size_t OFF_MK = OFF_MQ + (size_t)MROWS * 768 * 2;
constexpr size_t OFF_MV = OFF_MK + (size_t)MROWS * 768 * 2;
constexpr size_t WS_NEED = OFF_MV + (size_t)MROWS * 512 * 2;
constexpr size_t OFF_MERGED = OFF_MK;
constexpr size_t OFF_FF = OFF_PROJ;
static_assert((size_t)MROWS * 1024 * 2 <= (size_t)MROWS * (768 + 512) * 2, "merged fits");
static_assert((size_t)MROWS * 4096 * 2 <= (size_t)MROWS * (PROJ_LD + 768) * 2, "ff fits");

struct Params {
    const float *x, *meta, *ln1_g, *w_in, *cq_g, *ckv_g, *w_uq, *w_ukv, *mq_g, *mk_g, *dq_g, *dk_g, *dlam, *dout_g, *gate_b, *w_br, *w_out, *ln2_g, *w_ff1, *w_ff2;
    float* out; char* ws; int ph_lo, ph_hi, use_bar, never, tid, pad2;
};

DEVI unsigned cvt_pk(float lo, float hi) { unsigned r; asm("v_cvt_pk_bf16_f32 %0, %1, %2" : "=v"(r) : "v"(lo), "v"(hi)); return r; }
DEVI float bf2f(unsigned h) { return __uint_as_float(h << 16); }
DEVI int crow(int r, int hi) { return (r & 3) + 8 * (r >> 2) + 4 * hi; }
DEVI float* rowptr(const Params& p, int m) {
    if (m < NREAL) return p.out + (size_t)m * DM;
    const int i = (m - NREAL) & 127, b = (m - NREAL) >> 7;
    if (i >= PADN) return (float*)(p.ws + OFF_META) + (size_t)(b * NMETA + i - PADN) * DM;
    return nullptr;
}
#define MFMA(a, b, c) __builtin_amdgcn_mfma_f32_32x32x16_bf16(a, b, c, 0, 0, 0)

#define XB_TMO      128
#define XB_XCNT(j)  (256  + 64 * (j))
#define XB_XSUB(j)  (1280 + 64 * (j))
#define XB_XGEN(j)  (2304 + 64 * (j))
#define XB_TOP      3328
#define XB_TOPGEN   3392
#define XB_QUEUE(l) (4096 + 64 * (l))
#define XB_SPIN_CAP (1u << 22)
DEVI unsigned xb_ld(unsigned* p) { return __hip_atomic_load(p, __ATOMIC_RELAXED, __HIP_MEMORY_SCOPE_AGENT); }
DEVI unsigned xb_add(unsigned* p, unsigned v) { return __hip_atomic_fetch_add(p, v, __ATOMIC_RELAXED, __HIP_MEMORY_SCOPE_AGENT); }
DEVI unsigned xb_xcc_id() { return (unsigned)__builtin_amdgcn_s_getreg((3 << 11) | 20) & 0xFu; }
#define XB_SPIN(cond, bar) do { unsigned _sp = 0; while (cond) { __builtin_amdgcn_s_sleep(1); \
    if ((++_sp & 255u) == 0u) { if (xb_ld(&(bar)[XB_TMO])) break; if (_sp > XB_SPIN_CAP) { atomicAdd(&(bar)[XB_TMO], 1u); break; } } } } while (0)
struct XcdBarrier { unsigned* bar; unsigned x; volatile LAS unsigned* st; };
DEVI XcdBarrier xcd_barrier_post(unsigned* bar, volatile LAS unsigned* st) {
    XcdBarrier b; b.bar = bar; b.x = xb_xcc_id(); b.st = st;
    if (threadIdx.x == 0) (void)xb_add(&bar[XB_XCNT(b.x)], 1u);
    return b;
}
DEVI void xcd_barrier_complete(unsigned* bar, unsigned x, unsigned& nloc, unsigned& nx) {
    const unsigned G = gridDim.x * gridDim.y * gridDim.z;
    unsigned sum, cnt, mine, sp = 0u;
    for (;;) {
        sum = 0u; cnt = 0u; mine = 0u;
#pragma unroll
        for (unsigned j = 0; j < 16; ++j) { const unsigned c = xb_ld(&bar[XB_XCNT(j)]); sum += c; cnt += (c > 0u) ? 1u : 0u; mine = (j == x) ? c : mine; }
        if (sum == G) break;
        __builtin_amdgcn_s_sleep(1);
        if ((++sp & 255u) == 0u) { if (xb_ld(&bar[XB_TMO])) break; if (sp > XB_SPIN_CAP) { atomicAdd(&bar[XB_TMO], 1u); break; } }
    }
    nloc = mine > 0u ? mine : 1u; nx = cnt > 0u ? cnt : 1u;
}
DEVI void xcd_barrier(const XcdBarrier& b) {
    asm volatile("s_waitcnt vmcnt(0)" ::: "memory");
    __syncthreads();
    if (threadIdx.x == 0) {
        unsigned* bar = b.bar;
        __builtin_amdgcn_s_waitcnt(0);
        unsigned nloc = b.st[0], nx = b.st[1];
        if (nloc == 0u) { xcd_barrier_complete(bar, b.x, nloc, nx); b.st[0] = nloc; b.st[1] = nx; }
        const unsigned old = xb_add(&bar[XB_XSUB(b.x)], 1u);
        const unsigned gen = old / nloc;
        if (old + 1u == (gen + 1u) * nloc) {
            __builtin_amdgcn_fence(__ATOMIC_RELEASE, "agent");
            asm volatile("s_waitcnt vmcnt(0)" ::: "memory");
            const unsigned og = xb_add(&bar[XB_TOP], 1u);
            const unsigned tg = og / nx;
            if (og + 1u == (tg + 1u) * nx) xb_add(&bar[XB_TOPGEN], 1u);
            else XB_SPIN(xb_ld(&bar[XB_TOPGEN]) == tg, bar);
            __builtin_amdgcn_fence(__ATOMIC_ACQUIRE, "agent");
            xb_add(&bar[XB_XGEN(b.x)], 1u);
            asm volatile("s_waitcnt vmcnt(0)" ::: "memory");
        } else {
            XB_SPIN(xb_ld(&bar[XB_XGEN(b.x)]) == gen, bar);
            __builtin_amdgcn_fence(__ATOMIC_ACQUIRE, "agent");
            asm volatile("s_waitcnt vmcnt(0)" ::: "memory");
        }
    }
    __syncthreads();
}

DEVI void glds16(const void* g, unsigned lds_base) {
    unsigned sv; asm volatile("s_mov_b32 %0, m0\n\ts_mov_b32 m0, %2\n\ts_nop 0\n\tglobal_load_lds_dwordx4 %1, off\n\ts_mov_b32 m0, %0" : "=&s"(sv) : "v"(g), "s"(lds_base) : "memory"); }
template <int NB, int BK = (NB == 4 ? 32 : 64), int NST = (NB == 4 ? 3 : 2)>
DEVI void gemm_acc(const int TID, const bf16_t* __restrict__ A, int lda, const bf16_t* __restrict__ Bt, int ldb, int K, f32x16 (&acc)[2][NB], char* lds) {
    constexpr int ROWB = BK * 2, SLOTS = ROWB / 16, RPP = 1024 / ROWB, NA = 128 / RPP / 4, NBI = 64 * NB / RPP / 4, NI = NA + NBI, KS = BK / 16;
    constexpr int BOFF = 128 * ROWB, STAGE = (128 + 64 * NB) * ROWB;
    static_assert(NST * STAGE <= 73728, "LDS ring too large");
    const int tid = TID, lane = tid & 63, w = __builtin_amdgcn_readfirstlane(tid >> 6), wm = w >> 1, wn = w & 1, hi = lane >> 5, l32 = lane & 31;
    const int gsw = BK == 64 ? ((4 * (w & 1) + (lane >> 4)) & 7) : ((lane >> 4) & 3);
    const int gc = (lane % SLOTS) ^ gsw;
    const bf16_t* ag = A + (size_t)(RPP * w + lane / SLOTS) * lda + gc * 8;
    const bf16_t* bg = Bt + (size_t)(RPP * w + lane / SLOTS) * ldb + gc * 8;
    const int sw = BK == 64 ? ((l32 >> 1) & 7) : ((l32 >> 2) & 3);
    const int arow = (wm * 64 + l32) * ROWB, brow = BOFF + (wn * 32 * NB + l32) * ROWB;
    const int nk = K / BK;
    const unsigned lds0 = (unsigned)(uintptr_t)lds + w * 1024;
#define GEMM_ISSUE(kt_) do { const unsigned sd = (unsigned)__builtin_amdgcn_readfirstlane(lds0 + ((kt_) % NST) * STAGE); const int ko = (kt_) * BK; \
        _Pragma("unroll") for (int i = 0; i < NA; ++i) glds16(ag + (size_t)(4 * RPP * i) * lda + ko, sd + i * 4096); \
        _Pragma("unroll") for (int i = 0; i < NBI; ++i) glds16(bg + (size_t)(4 * RPP * i) * ldb + ko, sd + BOFF + i * 4096); } while (0)
#pragma unroll
    for (int i = 0; i < NST - 1; ++i) if (i < nk) GEMM_ISSUE(i);
    if (NST == 1) GEMM_ISSUE(0);
#pragma unroll 1
    for (int kt = 0; kt < nk; ++kt) {
        if (NST == 3 && kt + 1 < nk) asm volatile("s_waitcnt vmcnt(%0)\n\ts_barrier" :: "n"(NI) : "memory");
        else asm volatile("s_waitcnt vmcnt(0)\n\ts_barrier" ::: "memory");
        const char* st = lds + (kt % NST) * STAGE;
        bf16x8 af[KS][2], bfr[KS][NB];
#define GEMM_RD(ks_) do { const int ch = ((2 * (ks_) + hi) ^ sw) << 4; \
            af[ks_][0] = *(const bf16x8*)(st + arow + ch); af[ks_][1] = *(const bf16x8*)(st + arow + 32 * ROWB + ch); \
            _Pragma("unroll") for (int nb = 0; nb < NB; ++nb) bfr[ks_][nb] = *(const bf16x8*)(st + brow + nb * 32 * ROWB + ch); } while (0)
        GEMM_RD(0);
        __builtin_amdgcn_sched_barrier(0);
        if (NST > 1 && kt + NST - 1 < nk) GEMM_ISSUE(kt + NST - 1);
#pragma unroll
        for (int ks = 0; ks < KS; ++ks) {
            if (ks + 1 < KS) GEMM_RD(ks + 1);
#pragma unroll
            for (int nb = 0; nb < NB; ++nb) {
                acc[0][nb] = MFMA(af[ks][0], bfr[ks][nb], acc[0][nb]);
                acc[1][nb] = MFMA(af[ks][1], bfr[ks][nb], acc[1][nb]);
            }
            if (ks + 1 < KS) {
#pragma unroll
                for (int g = 0; g < (2 + NB + 1) / 2; ++g) { __builtin_amdgcn_sched_group_barrier(0x008, 2, 0); __builtin_amdgcn_sched_group_barrier(0x100, 2, 0); }
            }
            __builtin_amdgcn_sched_group_barrier(0x008, 2 * NB, 0);
            __builtin_amdgcn_sched_barrier(0);
        }
#undef GEMM_RD
        if (NST == 1 && kt + 1 < nk) { asm volatile("s_waitcnt lgkmcnt(0)\n\ts_barrier" ::: "memory"); GEMM_ISSUE(kt + 1); }
    }
    asm volatile("s_waitcnt lgkmcnt(0)\n\ts_barrier" ::: "memory");
#undef GEMM_ISSUE
}
template <int NB> DEVI void zero_acc(f32x16 (&acc)[2][NB]) {
#pragma unroll
    for (int a = 0; a < 2; ++a)
#pragma unroll
        for (int b = 0; b < NB; ++b)
#pragma unroll
            for (int r = 0; r < 16; ++r) acc[a][b][r] = 0.f;
}
DEVI void compute_rinv(const int TID, float* rinv, const float* part, int stride, int n, float div, int m0) {
    __syncthreads();
    const int t = TID;
    if (t < 128) {
        float s = 0.f;
        if (part) { for (int j = 0; j < n; ++j) s += part[(size_t)(m0 + t) * stride + j]; rinv[t] = rsqrtf(s / div + EPS); }
        else rinv[t] = 1.f;
    }
    __syncthreads();
}

DEVI void convert_tile(const int TID, const float* __restrict__ W, int ldw, int n0, int N, bf16_t* __restrict__ Wt, int Kdst, int tn, int tk, int kind,
                       const float* __restrict__ ks, float kconst, float* tile) {
    const int t = TID;
    const int nn = (t & 15) * 4;
#pragma unroll
    for (int i = 0; i < 4; ++i) {
        const int kk = (t >> 4) + 16 * i, kd = tk * 64 + kk;
        int sk = kd;
        if (kind == 4) { const int h = kd / 96, d = kd - h * 96; sk = d < 64 ? h * 64 + d : -1; }
        const int n = tn * 64 + nn;
        float4 v = make_float4(0.f, 0.f, 0.f, 0.f);
        if (sk >= 0 && n < N) {
            v = *(const float4*)(W + (size_t)sk * ldw + n0 + n);
            float s = kconst;
            if (ks) s *= (kind == 6) ? ks[sk & 127] : ks[sk];
            if (kind == 0 && n >= C_SBQ && n < C_SBK) s *= 0.125f * LOG2E;
            v.x *= s; v.y *= s; v.z *= s; v.w *= s;
        }
        float* d = tile + kk * 65 + nn;
        d[0] = v.x; d[1] = v.y; d[2] = v.z; d[3] = v.w;
    }
    __syncthreads();
    {
        const int n = t >> 2, kq = t & 3;
        unsigned pk[8];
#pragma unroll
        for (int j = 0; j < 8; ++j) pk[j] = cvt_pk(tile[(16 * kq + 2 * j) * 65 + n], tile[(16 * kq + 2 * j + 1) * 65 + n]);
        bf16_t* dst = Wt + (size_t)(tn * 64 + n) * Kdst + tk * 64 + 16 * kq;
        *(uint4*)dst = make_uint4(pk[0], pk[1], pk[2], pk[3]);
        *(uint4*)(dst + 8) = make_uint4(pk[4], pk[5], pk[6], pk[7]);
    }
    __syncthreads();
}

DEVI void phase_prep(const Params& p, int layer, char* lds) {
    bf16_t* Wb = (bf16_t*)(p.ws + OFF_W);
    float* tile = (float*)lds;
    const float lam_init = 0.8f - 0.6f * expf(-0.3f * (float)layer);
    struct Job { const float* W; const float* ks; bf16_t* Wt; int ldw, n0, N, Kdst, nt; float kc; };
    Job* jobs = (Job*)(lds + 32768);
    __syncthreads();
    if (p.tid < 10) {
        const int j = p.tid;
        Job jb; jb.n0 = 0; jb.ks = nullptr; jb.kc = 1.f; jb.ldw = 1024; jb.N = 1024; jb.Kdst = 1024;
        if (j == 0) { jb.W = p.w_in + (size_t)layer * DM * IN_COLS; jb.ldw = IN_COLS; jb.N = NMAIN; jb.Wt = Wb + W_IN; jb.ks = p.ln1_g + layer * DM; jb.nt = 56 * 16; }
        else if (j == 1) { jb.W = p.w_in + (size_t)layer * DM * IN_COLS; jb.ldw = IN_COLS; jb.n0 = NMAIN; jb.N = 3072; jb.Wt = Wb + W_GATE; jb.ks = p.ln1_g + layer * DM; jb.nt = 48 * 16; }
        else if (j == 2) { jb.W = p.w_uq + (size_t)layer * 256 * 768; jb.ldw = 768; jb.N = 768; jb.Kdst = 256; jb.Wt = Wb + W_UQ; jb.ks = p.cq_g + layer * 256; jb.nt = 12 * 4; }
        else if (j == 3) { jb.W = p.w_ukv + (size_t)layer * 128 * 1024; jb.Kdst = 128; jb.Wt = Wb + W_UKV; jb.ks = p.ckv_g + layer * 128; jb.nt = 16 * 2; }
        else if (j == 4) { jb.W = p.w_br + (size_t)layer * 1536 * 1024; jb.Kdst = 768; jb.Wt = Wb + W_BA; jb.nt = 16 * 12; }
        else if (j == 5) { jb.W = p.w_br + (size_t)layer * 1536 * 1024 + (size_t)512 * 1024; jb.Kdst = 512; jb.Wt = Wb + W_BB; jb.nt = 16 * 8; }
        else if (j == 6) { jb.W = p.w_br + (size_t)layer * 1536 * 1024 + (size_t)1024 * 1024; jb.Kdst = 512; jb.Wt = Wb + W_BC; jb.ks = p.dout_g + layer * 128; jb.kc = 1.f - lam_init; jb.nt = 16 * 8; }
        else if (j == 7) { jb.W = p.w_out + (size_t)layer * DM * DM; jb.Wt = Wb + W_OUT; jb.nt = 16 * 16; }
        else if (j == 8) { jb.W = p.w_ff1 + (size_t)layer * DM * 4096; jb.ldw = 4096; jb.N = 4096; jb.Wt = Wb + W_FF1; jb.ks = p.ln2_g + layer * DM; jb.nt = 64 * 16; }
        else { jb.W = p.w_ff2 + (size_t)layer * 4096 * DM; jb.Kdst = 4096; jb.Wt = Wb + W_FF2; jb.nt = 16 * 64; }
        jobs[j] = jb;
    }
    __syncthreads();
    int cum = 0;
#pragma unroll 1
    for (int j = 0; j < 10; ++j) {
        const Job jb = jobs[j];
        const int nkt = jb.Kdst / 64, G = (int)gridDim.x;
        const int t0 = ((int)blockIdx.x + G - (cum % G)) % G;
        for (int tt = t0; tt < jb.nt; tt += G) convert_tile(p.tid, jb.W, jb.ldw, jb.n0, jb.N, jb.Wt, jb.Kdst, tt / nkt, tt % nkt, j, jb.ks, jb.kc, tile);
        cum += jb.nt;
    }
    if (blockIdx.x == 0 && p.tid < 64) {
        const int l = p.tid;
        float a = fmaxf(fabsf(p.mq_g[layer * 96 + l]), l < 32 ? fabsf(p.mq_g[layer * 96 + 64 + l]) : 0.f);
        float b = fmaxf(fabsf(p.mk_g[layer * 96 + l]), l < 32 ? fabsf(p.mk_g[layer * 96 + 64 + l]) : 0.f);
        float c = fabsf(p.dq_g[layer * 64 + l]), d = fabsf(p.dk_g[layer * 64 + l]);
        const float* lp = p.dlam + layer * 256;
        float s1 = lp[l] * lp[64 + l], s2 = lp[128 + l] * lp[192 + l];
#pragma unroll
        for (int o = 32; o >= 1; o >>= 1) {
            a = fmaxf(a, __shfl_xor(a, o)); b = fmaxf(b, __shfl_xor(b, o)); c = fmaxf(c, __shfl_xor(c, o)); d = fmaxf(d, __shfl_xor(d, o));
            s1 += __shfl_xor(s1, o); s2 += __shfl_xor(s2, o);
        }
        if (l == 0) {
            float* cs = (float*)(p.ws + OFF_CONST) + layer * 16;
            cs[0] = sqrtf(96.f) * a * b * LOG2E;
            cs[1] = 8.f * c * d * LOG2E;
            cs[2] = expf(s1) - expf(s2) + lam_init;
        }
    }
    if (layer == 0) {
        bf16_t* hb = (bf16_t*)(p.ws + OFF_HB);
        float* part = (float*)(p.ws + OFF_PART);
        const int lane = p.tid & 63, wv = blockIdx.x * 4 + (p.tid >> 6), nwv = gridDim.x * 4;
        for (int m = wv; m < MROWS; m += nwv) {
            f32x4 v[4];
            const int mi = (m - NREAL) & 127;
            const float* src = m < NREAL ? p.x + (size_t)m * DM : (mi >= PADN ? p.meta + (size_t)(mi - PADN) * DM : nullptr);
#pragma unroll
            for (int i = 0; i < 4; ++i) v[i] = src ? *(const f32x4*)(src + lane * 16 + i * 4) : (f32x4){0.f, 0.f, 0.f, 0.f};
            float* dst = rowptr(p, m);
            float s = 0.f;
#pragma unroll
            for (int i = 0; i < 4; ++i) {
                if (dst && m >= NREAL) *(f32x4*)(dst + lane * 16 + i * 4) = v[i];
                s += v[i].x * v[i].x + v[i].y * v[i].y + v[i].z * v[i].z + v[i].w * v[i].w;
            }
            u32x4 h0 = (u32x4){cvt_pk(v[0].x, v[0].y), cvt_pk(v[0].z, v[0].w), cvt_pk(v[1].x, v[1].y), cvt_pk(v[1].z, v[1].w)};
            u32x4 h1 = (u32x4){cvt_pk(v[2].x, v[2].y), cvt_pk(v[2].z, v[2].w), cvt_pk(v[3].x, v[3].y), cvt_pk(v[3].z, v[3].w)};
            *(u32x4*)(hb + (size_t)m * DM + lane * 16) = h0;
            *(u32x4*)(hb + (size_t)m * DM + lane * 16 + 8) = h1;
            s += __shfl_xor(s, 1); s += __shfl_xor(s, 2);
            if ((lane & 3) == 0) part[(size_t)m * 16 + (lane >> 2)] = s;
        }
    }
}


typedef float f32x4v __attribute__((ext_vector_type(4)));
DEVI int meta_row0(int b) { return NREAL + b * 128 + PADN; }
DEVI void mini_gemm(const int TID, const bf16_t* __restrict__ A, int lda, const bf16_t* __restrict__ Wt, int ldb, int K, float (&v)[4], char* lds) {
    const int lane = TID & 63, w = TID >> 6, r16 = lane & 15, kg = lane >> 4, kq = K >> 2;
    f32x4v acc[4];
#pragma unroll
    for (int cb = 0; cb < 4; ++cb) acc[cb] = (f32x4v){0.f, 0.f, 0.f, 0.f};
    const bf16_t* ap = A + (size_t)r16 * lda + w * kq + kg * 8;
    const bf16_t* bp = Wt + (size_t)r16 * ldb + w * kq + kg * 8;
#pragma unroll 4
    for (int k = 0; k < kq; k += 32) {
        typedef __attribute__((address_space(1))) const bf16x8 gfrag_t;
        const bf16x8 a = *(gfrag_t*)(ap + k);
#pragma unroll
        for (int cb = 0; cb < 4; ++cb) {
            const bf16x8 bb = *(gfrag_t*)(bp + (size_t)(cb * 16) * ldb + k);
            acc[cb] = __builtin_amdgcn_mfma_f32_16x16x32_bf16(a, bb, acc[cb], 0, 0, 0);
        }
    }
    float* red = (float*)lds;
    __syncthreads();
#pragma unroll
    for (int cb = 0; cb < 4; ++cb)
#pragma unroll
        for (int j = 0; j < 4; ++j) red[((w * 4 + cb) * 4 + j) * 64 + lane] = acc[cb][j];
    __syncthreads();
#pragma unroll
    for (int j = 0; j < 4; ++j) v[j] = (red[((0 * 4 + w) * 4 + j) * 64 + lane] + red[((1 * 4 + w) * 4 + j) * 64 + lane]) + (red[((2 * 4 + w) * 4 + j) * 64 + lane] + red[((3 * 4 + w) * 4 + j) * 64 + lane]);
}
DEVI void mini_rinv(const int TID, float* rinv, const float* part, int stride, int n, float div, int m0) {
    __syncthreads();
    if (TID < 16) { float s = 0.f; for (int j = 0; j < n; ++j) s += part[(size_t)(m0 + TID) * stride + j]; rinv[TID] = rsqrtf(s / div + EPS); }
    __syncthreads();
}
DEVI void mini_rowsum(const int TID, float (&sq)[4], char* lds) {
    const int lane = TID & 63, w = TID >> 6;
#pragma unroll
    for (int j = 0; j < 4; ++j) { float x = sq[j]; x += __shfl_xor(x, 1); x += __shfl_xor(x, 2); x += __shfl_xor(x, 4); x += __shfl_xor(x, 8); sq[j] = x; }
    float* red = (float*)lds + 4096;
    __syncthreads();
    if ((lane & 15) == 0) {
#pragma unroll
        for (int j = 0; j < 4; ++j) red[w * 16 + (lane >> 4) * 4 + j] = sq[j];
    }
    __syncthreads();
#pragma unroll
    for (int j = 0; j < 4; ++j) { const int r = (lane >> 4) * 4 + j; sq[j] = (red[r] + red[16 + r]) + (red[32 + r] + red[48 + r]); }
}

DEVI void phase_inproj(const Params& p, char* lds, float* rinv) {
    const bf16_t* hb = (const bf16_t*)(p.ws + OFF_HB);
    const bf16_t* Wt = (const bf16_t*)(p.ws + OFF_W) + W_IN;
    bf16_t* proj = (bf16_t*)(p.ws + OFF_PROJ);
    const float* part = (const float*)(p.ws + OFF_PART);
    float* pcq = (float*)(p.ws + OFF_PCQ); float* pckv = (float*)(p.ws + OFF_PCKV);
    const int lane = p.tid & 63, w = p.tid >> 6, wm = w >> 1, wn = w & 1, hi = lane >> 5, l32 = lane & 31;
    const int ntiles = MT_REAL * 28;
    for (int t = blockIdx.x; t < ntiles; t += gridDim.x) {
        const int mt = t % MT_REAL, nt = t / MT_REAL, m0 = mt * 128, n0 = nt * 128;
        compute_rinv(p.tid, rinv, part, 16, 16, 1024.f, m0);
        f32x16 acc[2][2]; zero_acc<2>(acc);
        gemm_acc<2>(p.tid, hb + (size_t)m0 * DM, DM, Wt + (size_t)n0 * DM, DM, DM, acc, lds);
        const unsigned po = (unsigned)(m0 + wm * 64 + 4 * hi) * PROJ_LD + (unsigned)(n0 + wn * 64 + l32);
#pragma unroll
        for (int mb = 0; mb < 2; ++mb)
#pragma unroll
            for (int rh = 0; rh < 2; ++rh) {
                float sq[8];
#pragma unroll
                for (int k = 0; k < 8; ++k) {
                    const int r = 8 * rh + k;
                    const float ri = rinv[wm * 64 + mb * 32 + crow(r, hi)];
                    const unsigned o = po + (unsigned)(mb * 32 + (r & 3) + 8 * (r >> 2)) * PROJ_LD;
                    const float v0 = acc[mb][0][r] * ri, v1 = acc[mb][1][r] * ri;
                    ((gbf16_t*)proj)[o] = (bf16_t)(cvt_pk(v0, 0.f) & 0xffffu); ((gbf16_t*)proj)[o + 32] = (bf16_t)(cvt_pk(v1, 0.f) & 0xffffu);
                    sq[k] = v0 * v0 + v1 * v1;
                }
                if (nt <= 2) {
#pragma unroll
                    for (int o = 16; o >= 1; o >>= 1) {
                        float tq[8];
#pragma unroll
                        for (int k = 0; k < 8; ++k) tq[k] = __shfl_xor(sq[k], o);
#pragma unroll
                        for (int k = 0; k < 8; ++k) sq[k] += tq[k];
                    }
                    if (l32 == 0) {
#pragma unroll
                        for (int k = 0; k < 8; ++k) { const int m = m0 + wm * 64 + mb * 32 + crow(8 * rh + k, hi); if (nt < 2) pcq[(size_t)m * 4 + nt * 2 + wn] = sq[k]; else pckv[(size_t)m * 2 + wn] = sq[k]; }
                    }
                }
                __builtin_amdgcn_sched_barrier(0);
            }
    }
    for (int pc = blockIdx.x; pc < 4 * 56; pc += gridDim.x) {
        const int b = pc & 3, g = pc >> 2, m0 = meta_row0(b);
        mini_rinv(p.tid, rinv, part, 16, 16, 1024.f, m0);
        float v[4], sq[4];
        mini_gemm(p.tid, hb + (size_t)m0 * DM, DM, Wt + (size_t)g * 64 * DM, DM, DM, v, lds);
        const int n = g * 64 + w * 16 + (lane & 15);
#pragma unroll
        for (int j = 0; j < 4; ++j) {
            const int rr = (lane >> 4) * 4 + j;
            const float val = v[j] * rinv[rr];
            sq[j] = val * val;
            proj[(size_t)(m0 + rr) * PROJ_LD + n] = (bf16_t)(cvt_pk(val, 0.f) & 0xffffu);
        }
        if (g < 6) {
            mini_rowsum(p.tid, sq, lds);
            if (w == 0 && (lane & 15) == 0) {
#pragma unroll
                for (int j = 0; j < 4; ++j) { const int m = m0 + (lane >> 4) * 4 + j; if (g < 4) pcq[(size_t)m * 4 + g] = sq[j]; else pckv[(size_t)m * 2 + g - 4] = sq[j]; }
            }
        }
    }
}

DEVI void phase_upproj(const Params& p, char* lds, float* rinv) {
    const bf16_t* proj = (const bf16_t*)(p.ws + OFF_PROJ);
    const bf16_t* Wb = (const bf16_t*)(p.ws + OFF_W);
    bf16_t* mq = (bf16_t*)(p.ws + OFF_MQ); bf16_t* mk = (bf16_t*)(p.ws + OFF_MK); bf16_t* mv = (bf16_t*)(p.ws + OFF_MV);
    const float* pcq = (const float*)(p.ws + OFF_PCQ); const float* pckv = (const float*)(p.ws + OFF_PCKV);
    const int lane = p.tid & 63, w = p.tid >> 6, wm = w >> 1, wn = w & 1, hi = lane >> 5, l32 = lane & 31;
    const int ntiles = MT_REAL * 14;
    for (int t = blockIdx.x; t < ntiles; t += gridDim.x) {
        const int mt = t % MT_REAL, nt = t / MT_REAL, m0 = mt * 128;
        f32x16 acc[2][2]; zero_acc<2>(acc);
        if (nt < 6) {
            compute_rinv(p.tid, rinv, pcq, 4, 4, 256.f, m0);
            gemm_acc<2>(p.tid, proj + (size_t)m0 * PROJ_LD + C_CQ, PROJ_LD, Wb + W_UQ + (size_t)nt * 128 * 256, 256, 256, acc, lds);
        } else {
            compute_rinv(p.tid, rinv, pckv, 2, 2, 128.f, m0);
            gemm_acc<2>(p.tid, proj + (size_t)m0 * PROJ_LD + C_CKV, PROJ_LD, Wb + W_UKV + (size_t)(nt - 6) * 128 * 128, 128, 128, acc, lds);
        }
#pragma unroll
        for (int mb = 0; mb < 2; ++mb)
#pragma unroll
            for (int r = 0; r < 16; ++r) {
                const int rl = wm * 64 + mb * 32 + crow(r, hi), m = m0 + rl;
                const float ri = rinv[rl];
#pragma unroll
                for (int nb = 0; nb < 2; ++nb) {
                    const int c = nb * 32 + l32;
                    const bf16_t v = (bf16_t)(cvt_pk(acc[mb][nb][r] * ri, 0.f) & 0xffffu);
                    if (nt < 6) mq[(size_t)m * 768 + nt * 128 + wn * 64 + c] = v;
                    else { const int h = nt - 6; if (wn == 0) mk[(size_t)m * 768 + h * 96 + c] = v; else mv[(size_t)m * 512 + h * 64 + c] = v; }
                }
            }
    }
    for (int pc = blockIdx.x; pc < 4 * 28; pc += gridDim.x) {
        const int b = pc & 3, g = pc >> 2, m0 = meta_row0(b);
        float v[4];
        if (g < 12) { mini_rinv(p.tid, rinv, pcq, 4, 4, 256.f, m0); mini_gemm(p.tid, proj + (size_t)m0 * PROJ_LD + C_CQ, PROJ_LD, Wb + W_UQ + (size_t)g * 64 * 256, 256, 256, v, lds); }
        else { mini_rinv(p.tid, rinv, pckv, 2, 2, 128.f, m0); mini_gemm(p.tid, proj + (size_t)m0 * PROJ_LD + C_CKV, PROJ_LD, Wb + W_UKV + (size_t)(g - 12) * 64 * 128, 128, 128, v, lds); }
        const int c = w * 16 + (lane & 15);
#pragma unroll
        for (int j = 0; j < 4; ++j) {
            const int rr = (lane >> 4) * 4 + j, m = m0 + rr;
            const bf16_t o = (bf16_t)(cvt_pk(v[j] * rinv[rr], 0.f) & 0xffffu);
            if (g < 12) mq[(size_t)m * 768 + g * 64 + c] = o;
            else { const int h = (g - 12) >> 1; if (((g - 12) & 1) == 0) mk[(size_t)m * 768 + h * 96 + c] = o; else mv[(size_t)m * 512 + h * 64 + c] = o; }
        }
    }
}

DEVI void sincos_rev(float ang, float& c, float& s) {
    double rev = (double)ang * 0.15915494309189535;
    rev -= floor(rev);
    const float rf = (float)rev;
    s = __builtin_amdgcn_sinf(rf); c = __builtin_amdgcn_cosf(rf);
}
DEVI void ld8(const bf16_t* src, float* x) {
    const u32x4 u = *(const u32x4*)src;
    x[0] = bf2f(u.x & 0xffffu); x[1] = bf2f(u.x >> 16); x[2] = bf2f(u.y & 0xffffu); x[3] = bf2f(u.y >> 16);
    x[4] = bf2f(u.z & 0xffffu); x[5] = bf2f(u.z >> 16); x[6] = bf2f(u.w & 0xffffu); x[7] = bf2f(u.w >> 16);
}
DEVI void st8(bf16_t* dst, const float* x) {
    u32x4 uu = {cvt_pk(x[0], x[1]), cvt_pk(x[2], x[3]), cvt_pk(x[4], x[5]), cvt_pk(x[6], x[7])};
    *(u32x4*)dst = uu;
}
DEVI float sumsq8(const bf16_t* src) {
    float x[8]; ld8(src, x);
    return ((x[0] * x[0] + x[1] * x[1]) + (x[2] * x[2] + x[3] * x[3])) + ((x[4] * x[4] + x[5] * x[5]) + (x[6] * x[6] + x[7] * x[7]));
}
template <int D> DEVI void rope_pair(const bf16_t* pa, const bf16_t* pb, bf16_t* da, bf16_t* db, const float* ga, const float* gb, int i0, float pos, float ri, float os) {
    float a[8], b[8]; ld8(pa, a); ld8(pb, b);
#pragma unroll
    for (int e = 0; e < 8; ++e) {
        const float invf = __builtin_amdgcn_exp2f(-13.287712379549449f * (2.0f * (float)(i0 + e) / (float)D));
        float c, s; sincos_rev(pos * invf, c, s);
        const float ya = a[e] * ri * ga[e], yb = b[e] * ri * gb[e];
        a[e] = (ya * c - yb * s) * os; b[e] = (ya * s + yb * c) * os;
    }
    st8(da, a); st8(db, b);
}
DEVI void phase_normrope(const Params& p, int layer, char* lds) {
    float* gl = (float*)lds;
    __syncthreads();
    if (p.tid < 96) { gl[p.tid] = p.mq_g[layer * 96 + p.tid]; gl[96 + p.tid] = p.mk_g[layer * 96 + p.tid]; }
    if (p.tid < 64) { gl[192 + p.tid] = p.dq_g[layer * 64 + p.tid]; gl[256 + p.tid] = p.dk_g[layer * 64 + p.tid]; }
    __syncthreads();
    bf16_t* proj = (bf16_t*)(p.ws + OFF_PROJ);
    bf16_t* mq = (bf16_t*)(p.ws + OFF_MQ); bf16_t* mk = (bf16_t*)(p.ws + OFF_MK);
    const int total = MROWS * 32, nth = gridDim.x * NTHREADS;
    for (int it = blockIdx.x * NTHREADS + p.tid; it < total; it += nth) {
        const int m = it >> 5, j = it & 31;
        const int mi = (m - NREAL) & 127;
        const float pos = (float)(m < NREAL ? NMETA + (m & (SEQ - 1)) : (mi > PADN ? mi - PADN : 0));
        if (m >= NREAL && mi < PADN) continue;
        if (j < 16) {
            const int h = j & 7;
            const bool isq = j < 8;
            bf16_t* dst = (isq ? mq : mk) + (size_t)m * 768 + h * 96;
            const bf16_t* rsrc = isq ? dst + 64 : proj + (size_t)m * PROJ_LD + C_KR;
            const float* g = gl + (isq ? 0 : 96);
            const float os = isq ? 0.10206207261596575f * LOG2E : 1.f;
            float ss = 0.f;
#pragma unroll
            for (int c = 0; c < 8; ++c) ss += sumsq8(dst + c * 8);
#pragma unroll
            for (int c = 0; c < 4; ++c) ss += sumsq8(rsrc + c * 8);
            const float ri = rsqrtf(ss * (1.f / 96.f) + EPS);
#pragma unroll
            for (int c = 0; c < 8; ++c) {
                float x[8]; ld8(dst + c * 8, x);
#pragma unroll
                for (int e = 0; e < 8; ++e) x[e] = x[e] * ri * g[c * 8 + e] * os;
                st8(dst + c * 8, x);
            }
#pragma unroll
            for (int c = 0; c < 2; ++c)
                rope_pair<32>(rsrc + c * 8, rsrc + 16 + c * 8, dst + 64 + c * 8, dst + 80 + c * 8, g + 64 + c * 8, g + 80 + c * 8, c * 8, pos, ri, os);
        } else {
            const int idx = j & 7;
            const bool isq = j < 24;
            bf16_t* dst = proj + (size_t)m * PROJ_LD + (isq ? C_DQ : C_DK) + idx * 64;
            const float* g = gl + (isq ? 192 : 256);
            const float os = isq ? 0.125f * LOG2E : 1.f;
            float ss = 0.f;
#pragma unroll
            for (int c = 0; c < 8; ++c) ss += sumsq8(dst + c * 8);
            const float ri = rsqrtf(ss * (1.f / 64.f) + EPS);
#pragma unroll
            for (int c = 0; c < 4; ++c)
                rope_pair<64>(dst + c * 8, dst + 32 + c * 8, dst + c * 8, dst + 32 + c * 8, g + c * 8, g + 32 + c * 8, c * 8, pos, ri, os);
        }
    }
}

DEVI s16x4 vtr(lds_cptr p) { return __builtin_bit_cast(s16x4, __builtin_amdgcn_ds_read_tr16_b64_v4i16((LAS v4i16_t*)p)); }

template <int DQK, int DV, int MODE>
DEVI void attn_pass(const int TID, const bf16_t* __restrict__ Qp, int ldq, const bf16_t* __restrict__ Kp, int ldk, const bf16_t* __restrict__ Vp, int ldv,
                    int b, int qt, float Mb, f32x16 (&O)[DV / 32], float& lsum, char* lds, volatile int* flags) {
    constexpr int NDS = DQK / 16, NKL = DQK / 32, NVL = DV / 32, NDB = DV / 32, ATT_VOFF = 64 * DQK * 2, ATT_STAGE = ATT_VOFF + 64 * DV * 2;
    const int tid = TID, lane = tid & 63, w = tid >> 6, hi = lane >> 5, l32 = lane & 31;
    const int qrow = 128 * qt + 32 * w + l32, qmax = 128 * qt + 32 * w + 31;
    bf16x8 qf[NDS];
    const int qg = (qt == 0 ? NREAL + b * 128 : b * SEQ + 128 * (qt - 1)) + 32 * w + l32;
#define KROW(kt_) ((kt_) < 2 ? NREAL + b * 128 + 64 * (kt_) : b * SEQ + 64 * (kt_) - 128)
#pragma unroll
    for (int ds = 0; ds < NDS; ++ds) qf[ds] = *(const bf16x8*)(Qp + (size_t)qg * ldq + 16 * ds + 8 * hi);
#pragma unroll
    for (int ds = 0; ds < NDS; ++ds) asm volatile("" : "+v"(qf[ds]));
#pragma unroll
    for (int db = 0; db < NDB; ++db)
#pragma unroll
        for (int r = 0; r < 16; ++r) O[db][r] = 0.f;
    lsum = 0.f;
    float carry = 0.f;
    const int kt_last = 2 * qt + 1, ntile = kt_last;
    const int wu = __builtin_amdgcn_readfirstlane(w);
    const bf16_t* kg = Kp + (size_t)lane * ldk + wu * 8;
    const bf16_t* vg = Vp + (size_t)(tid >> 2) * ldv + (tid & 3) * 8;
    const int vbase = ATT_VOFF + (4 * hi + ((lane & 15) >> 2)) * 64 + ((lane >> 4) & 1) * 32 + (lane & 3) * 8;
    const int kbase = hi * 1024 + l32 * 16;
    const unsigned ldsb = (unsigned)(uintptr_t)lds + wu * 1024;
#define ATT_ISSUE(kt_, stg_) do { const int kr = KROW(kt_); const unsigned sd = (unsigned)__builtin_amdgcn_readfirstlane(ldsb + (stg_) * ATT_STAGE); \
        _Pragma("unroll") for (int i = 0; i < NKL; ++i) glds16(kg + (size_t)kr * ldk + 32 * i, sd + i * 4096); \
        _Pragma("unroll") for (int i = 0; i < NVL; ++i) glds16(vg + (size_t)kr * ldv + 32 * i, sd + ATT_VOFF + i * 4096); } while (0)
    ATT_ISSUE(MODE == 1 ? kt_last : 1, 0);
#pragma unroll 1
    for (int it = 0; it < ntile; ++it) {
        const int kt = MODE == 1 ? kt_last - it : 1 + it;
        const char* st = lds + (it & 1) * ATT_STAGE;
        asm volatile("s_waitcnt vmcnt(0) lgkmcnt(0)\n\ts_barrier" ::: "memory");
        if (MODE == 1 && it > 0) {
            const volatile int* f = flags + ((it - 1) & 1) * 4;
            if (f[0] & f[1] & f[2] & f[3]) break;
        }
        if (it + 1 < ntile) ATT_ISSUE(MODE == 1 ? kt - 1 : kt + 1, (it + 1) & 1);
        int done = 0;
        if (64 * kt <= qmax) {
            bf16x8 pf[4];
            float cb = carry;
            const bool need_mask = (kt >= 2 * qt) || (kt == 1);
#pragma unroll
            for (int kk = 0; kk < 2; ++kk) {
                const int kb = MODE == 1 ? 1 - kk : kk;
                f32x16 S;
#pragma unroll
                for (int r = 0; r < 16; ++r) S[r] = MODE == 0 ? -Mb : 0.f;
                bf16x8 kf[NDS];
#pragma unroll
                for (int ds = 0; ds < NDS; ++ds) kf[ds] = *(const bf16x8*)(st + kbase + ds * 2048 + kb * 512);
                __builtin_amdgcn_sched_barrier(0);
#pragma unroll
                for (int ds = 0; ds < NDS; ++ds) S = MFMA(kf[ds], qf[ds], S);
                if (MODE == 0) {
#pragma unroll
                    for (int r = 0; r < 16; ++r) {
                        float pv = __builtin_amdgcn_exp2f(S[r]);
                        if (need_mask) { const int key = 64 * kt + 32 * kb + crow(r, hi); pv = (key <= qrow && key >= PADN) ? pv : 0.f; }
                        S[r] = pv; lsum += pv;
                    }
                } else {
                    float lk[16], T[4], U[4];
#pragma unroll
                    for (int r = 0; r < 16; ++r) {
                        const int key = 64 * kt + 32 * kb + crow(r, hi);
                        const bool valid = (key < qrow) && (key >= PADN);
                        const float z = S[r];
                        const float sp = fmaxf(z, 0.f) + __builtin_amdgcn_logf(1.f + __builtin_amdgcn_exp2f(-fabsf(z)));
                        lk[r] = valid ? -sp : 0.f;
                        S[r] = valid ? z - sp : -INFINITY;
                    }
#pragma unroll
                    for (int g = 0; g < 4; ++g) { T[g] = (lk[4 * g] + lk[4 * g + 1]) + (lk[4 * g + 2] + lk[4 * g + 3]); U[g] = __shfl_xor(T[g], 32); }
                    float acc_hi = cb;
#pragma unroll
                    for (int g = 3; g >= 0; --g) {
                        float run = acc_hi + (hi == 0 ? U[g] : 0.f);
#pragma unroll
                        for (int i = 3; i >= 0; --i) { const int r = 4 * g + i; S[r] = __builtin_amdgcn_exp2f(S[r] + run); run += lk[r]; }
                        acc_hi += T[g] + U[g];
                    }
                    cb = acc_hi;
                }
#pragma unroll
                for (int c = 0; c < 2; ++c) {
                    u32x4 uu = {cvt_pk(S[8 * c + 0], S[8 * c + 1]), cvt_pk(S[8 * c + 2], S[8 * c + 3]), cvt_pk(S[8 * c + 4], S[8 * c + 5]), cvt_pk(S[8 * c + 6], S[8 * c + 7])};
                    pf[2 * kb + c] = __builtin_bit_cast(bf16x8, uu);
                }
                if (DV == 128) __builtin_amdgcn_sched_barrier(0);
            }
            carry = cb;
            {
                constexpr int NG = 2 * NDB;
                s16x4 vb[2][4];
#define ATT_VRD(gi_, buf_) do { const int db_ = (gi_) >> 1, k2_ = (gi_) & 1; \
                    _Pragma("unroll") for (int kc = 0; kc < 2; ++kc) { vb[buf_][2 * kc] = vtr((lds_cptr)(st + vbase + db_ * 4096 + (2 * k2_ + kc) * 1024)); \
                        vb[buf_][2 * kc + 1] = vtr((lds_cptr)(st + vbase + db_ * 4096 + (2 * k2_ + kc) * 1024 + 512)); } } while (0)
                ATT_VRD(0, 0);
                __builtin_amdgcn_sched_barrier(0);
#pragma unroll
                for (int gi = 0; gi < NG; ++gi) {
                    if (gi + 1 < NG) ATT_VRD(gi + 1, (gi + 1) & 1);
#pragma unroll
                    for (int kc = 0; kc < 2; ++kc) {
                        const s16x4 lo = vb[gi & 1][2 * kc], h4 = vb[gi & 1][2 * kc + 1];
                        const bf16x8 vt = {lo[0], lo[1], lo[2], lo[3], h4[0], h4[1], h4[2], h4[3]};
                        O[gi >> 1] = MFMA(vt, pf[2 * (gi & 1) + kc], O[gi >> 1]);
                    }
                    if (gi + 1 < NG) __builtin_amdgcn_sched_group_barrier(0x100, 4, 0);
                    __builtin_amdgcn_sched_group_barrier(0x008, 2, 0);
                    __builtin_amdgcn_sched_barrier(0);
                }
#undef ATT_VRD
            }
            if (MODE == 1) done = __all(carry < -152.f) ? 1 : 0;
        }
        if (MODE == 1 && lane == 0) flags[(it & 1) * 4 + w] = done;
    }
    asm volatile("s_waitcnt vmcnt(0) lgkmcnt(0)\n\ts_barrier" ::: "memory");
#undef KROW
#undef ATT_ISSUE
}

template <int NDB> DEVI void store_o(bf16_t* Op, int ldo, int qrow, int hi, const f32x16 (&O)[NDB], float scale) {
#pragma unroll
    for (int db = 0; db < NDB; ++db)
#pragma unroll
        for (int g = 0; g < 4; ++g) {
            u32x2 v; v.x = cvt_pk(O[db][4 * g] * scale, O[db][4 * g + 1] * scale); v.y = cvt_pk(O[db][4 * g + 2] * scale, O[db][4 * g + 3] * scale);
            *(u32x2*)(Op + (size_t)qrow * ldo + 32 * db + 8 * g + 4 * hi) = v;
        }
}

DEVI void phase_attn(const Params& p, int layer, char* lds, int* sh) {
    bf16_t* proj = (bf16_t*)(p.ws + OFF_PROJ);
    bf16_t* mq = (bf16_t*)(p.ws + OFF_MQ); bf16_t* mk = (bf16_t*)(p.ws + OFF_MK); bf16_t* mv = (bf16_t*)(p.ws + OFF_MV);
    unsigned* ctr = (unsigned*)(p.ws + OFF_BAR) + XB_QUEUE(layer + 2 * p.pad2);
    const float* cs = (const float*)(p.ws + OFF_CONST) + layer * 16;
    const float Mb_mla = cs[0], Mb_diff = cs[1], lam = cs[2];
    const int tid = p.tid, lane = tid & 63, w = tid >> 6, hi = lane >> 5, l32 = lane & 31;
    volatile int* flags = sh + 8;
    const int NUNITS = NQT * 80;
    for (;;) {
        __syncthreads();
        if (tid == 0) sh[0] = (int)atomicAdd(ctr, 1u);
        __syncthreads();
        const int u = sh[0];
        if (u >= NUNITS) break;
        const int qt = 32 - u / 80, v = u % 80;
#ifndef ATT_ONLY
#define ATT_ONLY -1
#endif
        if (v < 16 && (ATT_ONLY < 0 || ATT_ONLY == 0)) {
            int tl = p.tid; asm volatile("" : "+v"(tl));
            const int b = v >> 2, h = v & 3;
            const int qrow = (qt == 0 ? NREAL + b * 128 : b * SEQ + 128 * (qt - 1)) + 32 * w + l32;
            bf16_t* base = proj;
            bf16_t* Q1 = base + C_DQ + h * 128; const bf16_t* K1 = base + C_DK + h * 128; const bf16_t* V = base + C_DV + h * 128;
            f32x16 O[4]; float l1, l2;
            attn_pass<64, 128, 0>(tl, Q1, PROJ_LD, K1, PROJ_LD, V, PROJ_LD, b, qt, Mb_diff, O, l1, lds, flags);
            l1 += __shfl_xor(l1, 32);
            const float i1 = l1 > 0.f ? 1.f / l1 : 0.f;
            unsigned o1p[1][8];
            u32x4* stash = (u32x4*)(lds + 49152) + tid;
#pragma unroll
            for (int db = 0; db < 1; ++db)
#pragma unroll
                for (int r = 0; r < 8; ++r) o1p[db][r] = cvt_pk(O[db][2 * r] * i1, O[db][2 * r + 1] * i1);
#pragma unroll
            for (int db = 1; db < 4; ++db)
#pragma unroll
                for (int c = 0; c < 2; ++c) {
                    u32x4 uu = {cvt_pk(O[db][8 * c] * i1, O[db][8 * c + 1] * i1), cvt_pk(O[db][8 * c + 2] * i1, O[db][8 * c + 3] * i1),
                                cvt_pk(O[db][8 * c + 4] * i1, O[db][8 * c + 5] * i1), cvt_pk(O[db][8 * c + 6] * i1, O[db][8 * c + 7] * i1)};
                    stash[((db - 1) * 2 + c) * 256] = uu;
                }
            attn_pass<64, 128, 0>(tl, Q1 + 64, PROJ_LD, K1 + 64, PROJ_LD, V, PROJ_LD, b, qt, Mb_diff, O, l2, lds, flags);
            l2 += __shfl_xor(l2, 32);
            const float i2 = l2 > 0.f ? lam / l2 : 0.f;
            float ss = 0.f;
#pragma unroll
            for (int db = 0; db < 1; ++db)
#pragma unroll
                for (int r = 0; r < 8; ++r) {
                    const float a = bf2f(o1p[db][r] & 0xffffu) - O[db][2 * r] * i2, c = bf2f(o1p[db][r] >> 16) - O[db][2 * r + 1] * i2;
                    O[db][2 * r] = a; O[db][2 * r + 1] = c; ss += a * a + c * c;
                }
#pragma unroll
            for (int db = 1; db < 4; ++db)
#pragma unroll
                for (int c = 0; c < 2; ++c) {
                    const u32x4 uu = stash[((db - 1) * 2 + c) * 256];
#pragma unroll
                    for (int e = 0; e < 4; ++e) {
                        const int r = 8 * c + 2 * e;
                        const float a = bf2f(uu[e] & 0xffffu) - O[db][r] * i2, cc = bf2f(uu[e] >> 16) - O[db][r + 1] * i2;
                        O[db][r] = a; O[db][r + 1] = cc; ss += a * a + cc * cc;
                    }
                }
            ss += __shfl_xor(ss, 32);
            const float ri = rsqrtf(ss * (1.f / 128.f) + EPS);
            if (!p.pad2) store_o<4>(Q1, PROJ_LD, qrow, hi, O, ri);
        } else if (v >= 16 && v < 48 && (ATT_ONLY < 0 || ATT_ONLY == 1)) {
            int tl = p.tid; asm volatile("" : "+v"(tl));
            const int vv = v - 16, b = vv >> 3, h = vv & 7;
            const int qrow = (qt == 0 ? NREAL + b * 128 : b * SEQ + 128 * (qt - 1)) + 32 * w + l32;
            bf16_t* Q = mq + h * 96;
            const bf16_t* K = mk + h * 96;
            const bf16_t* V = mv + h * 64;
            f32x16 O[2]; float l;
            attn_pass<96, 64, 0>(tl, Q, 768, K, 768, V, 512, b, qt, Mb_mla, O, l, lds, flags);
            l += __shfl_xor(l, 32);
            if (!p.pad2) store_o<2>(Q, 768, qrow, hi, O, l > 0.f ? 1.f / l : 0.f);
        } else if (v >= 48 && (ATT_ONLY < 0 || ATT_ONLY == 2)) {
            int tl = p.tid; asm volatile("" : "+v"(tl));
            const int vv = v - 48, b = vv >> 3, h = vv & 7;
            const int qrow = (qt == 0 ? NREAL + b * 128 : b * SEQ + 128 * (qt - 1)) + 32 * w + l32;
            bf16_t* base = proj;
            f32x16 O[2]; float l;
            attn_pass<64, 64, 1>(tl, base + C_SBQ + h * 64, PROJ_LD, base + C_SBK + h * 64, PROJ_LD, base + C_SBV + h * 64, PROJ_LD, b, qt, 0.f, O, l, lds, flags);
            if (!p.pad2) store_o<2>(base + C_SBQ + h * 64, PROJ_LD, qrow, hi, O, 1.f);
        }
    }
}

DEVI bf16_t* gate_ptr(const Params& p, int br, int m) {
    if (br == 0) return (bf16_t*)(p.ws + OFF_MERGED) + (size_t)m * DM;
    return (bf16_t*)(p.ws + OFF_PROJ) + (size_t)m * PROJ_LD + (br == 1 ? C_SBK : C_DK);
}
DEVI void phase_gates(const Params& p, int layer, char* lds, float* rinv) {
    const bf16_t* hb = (const bf16_t*)(p.ws + OFF_HB);
    const bf16_t* Wt = (const bf16_t*)(p.ws + OFF_W) + W_GATE;
    const float* part = (const float*)(p.ws + OFF_PART);
    const float* gb = p.gate_b + layer * 3072;
    const int lane = p.tid & 63, w = p.tid >> 6, wm = w >> 1, wn = w & 1, hi = lane >> 5, l32 = lane & 31;
    const int ntiles = MT_REAL * 12;
    for (int t = blockIdx.x; t < ntiles; t += gridDim.x) {
        const int mt = t % MT_REAL, nt = t / MT_REAL, m0 = mt * 128, n0 = nt * 256, br = nt >> 2;
        compute_rinv(p.tid, rinv, part, 16, 16, 1024.f, m0);
        f32x16 acc[2][4]; zero_acc<4>(acc);
        gemm_acc<4, 64, 1>(p.tid, hb + (size_t)m0 * DM, DM, Wt + (size_t)n0 * DM, DM, DM, acc, lds);
        float bias[4];
#pragma unroll
        for (int nb = 0; nb < 4; ++nb) bias[nb] = gb[n0 + wn * 128 + nb * 32 + l32];
        bf16_t* gbase = gate_ptr(p, br, 0); const unsigned gpitch = br == 0 ? DM : PROJ_LD;
        const unsigned go = (unsigned)(m0 + wm * 64 + 4 * hi) * gpitch + (unsigned)((n0 & 1023) + wn * 128 + l32);
#pragma unroll
        for (int mb = 0; mb < 2; ++mb)
#pragma unroll
            for (int r = 0; r < 16; ++r) {
                const int rl = wm * 64 + mb * 32 + crow(r, hi);
                const float ri = rinv[rl];
                const unsigned o = go + (unsigned)(mb * 32 + (r & 3) + 8 * (r >> 2)) * gpitch;
#pragma unroll
                for (int nb = 0; nb < 4; ++nb) {
                    const float z = acc[mb][nb][r] * ri + bias[nb];
                    ((gbf16_t*)gbase)[o + nb * 32] = (bf16_t)(cvt_pk(1.f / (1.f + __builtin_amdgcn_exp2f(-z * LOG2E)), 0.f) & 0xffffu);
                }
                if ((r & 3) == 3) __builtin_amdgcn_sched_barrier(0);
            }
    }
    for (int pc = blockIdx.x; pc < 4 * 48; pc += gridDim.x) {
        const int b = pc & 3, g = pc >> 2, m0 = meta_row0(b), br = g >> 4;
        mini_rinv(p.tid, rinv, part, 16, 16, 1024.f, m0);
        float v[4];
        mini_gemm(p.tid, hb + (size_t)m0 * DM, DM, Wt + (size_t)g * 64 * DM, DM, DM, v, lds);
        const int n = g * 64 + w * 16 + (lane & 15);
        const float bias = gb[n];
#pragma unroll
        for (int j = 0; j < 4; ++j) {
            const int rr = (lane >> 4) * 4 + j;
            const float z = v[j] * rinv[rr] + bias;
            gate_ptr(p, br, m0 + rr)[n & 1023] = (bf16_t)(cvt_pk(1.f / (1.f + __builtin_amdgcn_exp2f(-z * LOG2E)), 0.f) & 0xffffu);
        }
    }
}

DEVI void phase_merge(const Params& p, int layer, char* lds, float* rinv) {
    const bf16_t* Wb = (const bf16_t*)(p.ws + OFF_W);
    const bf16_t* proj = (const bf16_t*)(p.ws + OFF_PROJ);
    const bf16_t* mq = (const bf16_t*)(p.ws + OFF_MQ);
    bf16_t* merged = (bf16_t*)(p.ws + OFF_MERGED);
    const int lane = p.tid & 63, w = p.tid >> 6, wm = w >> 1, wn = w & 1, hi = lane >> 5, l32 = lane & 31;
    const int ntiles = MT_REAL * 8;
    for (int t = blockIdx.x; t < ntiles; t += gridDim.x) {
        const int mt = t % MT_REAL, nt = t / MT_REAL, m0 = mt * 128, n0 = nt * 128;
        f32x16 mg[2][2]; zero_acc<2>(mg);
#pragma unroll 1
        for (int br = 0; br < 3; ++br) {
            const bf16_t* A; int lda, K; const bf16_t* W;
            if (br == 0) { A = mq + (size_t)m0 * 768; lda = 768; K = 768; W = Wb + W_BA + (size_t)n0 * 768; }
            else if (br == 1) { A = proj + (size_t)m0 * PROJ_LD + C_SBQ; lda = PROJ_LD; K = 512; W = Wb + W_BB + (size_t)n0 * 512; }
            else { A = proj + (size_t)m0 * PROJ_LD + C_DQ; lda = PROJ_LD; K = 512; W = Wb + W_BC + (size_t)n0 * 512; }
            f32x16 acc[2][2]; zero_acc<2>(acc);
            gemm_acc<2>(p.tid, A, lda, W, K, K, acc, lds);
            const bf16_t* gbase = gate_ptr(p, br, 0); const unsigned gpitch = br == 0 ? DM : PROJ_LD;
            const unsigned go = (unsigned)(m0 + wm * 64 + 4 * hi) * gpitch + (unsigned)(n0 + wn * 64 + l32);
#pragma unroll
            for (int mb = 0; mb < 2; ++mb)
#pragma unroll
                for (int r = 0; r < 16; ++r) {
                    const unsigned o = go + (unsigned)(mb * 32 + (r & 3) + 8 * (r >> 2)) * gpitch;
#pragma unroll
                    for (int nb = 0; nb < 2; ++nb) mg[mb][nb][r] += bf2f(((const gbf16_t*)gbase)[o + nb * 32]) * acc[mb][nb][r];
                    if ((r & 7) == 7) __builtin_amdgcn_sched_barrier(0);
                }
        }
#pragma unroll
        for (int mb = 0; mb < 2; ++mb)
#pragma unroll
            for (int r = 0; r < 16; ++r) {
                const int m = m0 + wm * 64 + mb * 32 + crow(r, hi);
#pragma unroll
                for (int nb = 0; nb < 2; ++nb) merged[(size_t)m * DM + n0 + wn * 64 + nb * 32 + l32] = (bf16_t)(cvt_pk(mg[mb][nb][r], 0.f) & 0xffffu);
            }
    }
    for (int pc = blockIdx.x; pc < 4 * 16; pc += gridDim.x) {
        const int b = pc & 3, gq = pc >> 2, m0 = meta_row0(b), n0 = gq * 64;
        const int n = n0 + w * 16 + (lane & 15);
        float mg[4] = {0.f, 0.f, 0.f, 0.f};
#pragma unroll 1
        for (int br = 0; br < 3; ++br) {
            const bf16_t* A; int lda, K; const bf16_t* W;
            if (br == 0) { A = mq + (size_t)m0 * 768; lda = 768; K = 768; W = Wb + W_BA + (size_t)n0 * 768; }
            else if (br == 1) { A = proj + (size_t)m0 * PROJ_LD + C_SBQ; lda = PROJ_LD; K = 512; W = Wb + W_BB + (size_t)n0 * 512; }
            else { A = proj + (size_t)m0 * PROJ_LD + C_DQ; lda = PROJ_LD; K = 512; W = Wb + W_BC + (size_t)n0 * 512; }
            float v[4];
            mini_gemm(p.tid, A, lda, W, K, K, v, lds);
#pragma unroll
            for (int j = 0; j < 4; ++j) mg[j] += bf2f(gate_ptr(p, br, m0 + (lane >> 4) * 4 + j)[n]) * v[j];
        }
#pragma unroll
        for (int j = 0; j < 4; ++j) merged[(size_t)(m0 + (lane >> 4) * 4 + j) * DM + n] = (bf16_t)(cvt_pk(mg[j], 0.f) & 0xffffu);
    }
}

DEVI void phase_resid(const Params& p, const bf16_t* A, int K, const bf16_t* Wt, char* lds, const float* rsrc) {
    bf16_t* hb = (bf16_t*)(p.ws + OFF_HB);
    float* part = (float*)(p.ws + OFF_PART);
    const int lane = p.tid & 63, w = p.tid >> 6, wm = w >> 1, wn = w & 1, hi = lane >> 5, l32 = lane & 31;
    const int ntiles = MT_REAL * 4;
    for (int t = blockIdx.x; t < ntiles; t += gridDim.x) {
        const int mt = t % MT_REAL, nt = t / MT_REAL, m0 = mt * 128, n0 = nt * 256;
        f32x16 acc[2][4]; zero_acc<4>(acc);
        gemm_acc<4, 64, 1>(p.tid, A + (size_t)m0 * K, K, Wt + (size_t)n0 * K, K, K, acc, lds);
        gf32_t* outg = (gf32_t*)p.out; gbf16_t* hbg = (gbf16_t*)hb; const gf32_t* srcg = (const gf32_t*)rsrc;
        const unsigned ho = (unsigned)(m0 + wm * 64 + 4 * hi) * DM + (unsigned)(n0 + wn * 128 + l32);
#pragma unroll
        for (int mb = 0; mb < 2; ++mb)
#pragma unroll
            for (int rg = 0; rg < 4; ++rg) {
                float hv[4][4];
#pragma unroll
                for (int j = 0; j < 4; ++j)
#pragma unroll
                    for (int nb = 0; nb < 4; ++nb) hv[j][nb] = srcg[ho + (unsigned)(mb * 32 + 8 * rg + j) * DM + nb * 32];
                __builtin_amdgcn_sched_barrier(0);
                float sq[8];
#pragma unroll
                for (int j = 0; j < 4; ++j)
#pragma unroll
                    for (int nb = 0; nb < 4; ++nb) {
                        const float h = hv[j][nb] + acc[mb][nb][4 * rg + j];
                        const unsigned o = ho + (unsigned)(mb * 32 + 8 * rg + j) * DM + nb * 32;
                        if (!p.pad2) { outg[o] = h; hbg[o] = (bf16_t)(cvt_pk(h, 0.f) & 0xffffu); }
                        if ((nb & 1) == 0) sq[2 * j + (nb >> 1)] = h * h; else sq[2 * j + (nb >> 1)] += h * h;
                    }
#pragma unroll
                for (int o = 16; o >= 1; o >>= 1) {
                    float tq[8];
#pragma unroll
                    for (int k = 0; k < 8; ++k) tq[k] = __shfl_xor(sq[k], o);
#pragma unroll
                    for (int k = 0; k < 8; ++k) sq[k] += tq[k];
                }
                if (l32 == 0 && !p.pad2) {
#pragma unroll
                    for (int j = 0; j < 4; ++j) {
                        float* pp = part + (size_t)(m0 + wm * 64 + mb * 32 + 8 * rg + 4 * hi + j) * 16 + nt * 4 + wn * 2;
                        pp[0] = sq[2 * j]; pp[1] = sq[2 * j + 1];
                    }
                }
                __builtin_amdgcn_sched_barrier(0);
            }
    }
    for (int pc = blockIdx.x; pc < 4 * 16; pc += gridDim.x) {
        const int b = pc & 3, g = pc >> 2, m0 = meta_row0(b);
        float v[4], sq[4];
        mini_gemm(p.tid, A + (size_t)m0 * K, K, Wt + (size_t)g * 64 * K, K, K, v, lds);
        const int n = g * 64 + w * 16 + (lane & 15);
#pragma unroll
        for (int j = 0; j < 4; ++j) {
            const int m = m0 + (lane >> 4) * 4 + j;
            float* hp = rowptr(p, m);
            const float h = hp[n] + v[j];
            if (!p.pad2) { hp[n] = h; hb[(size_t)m * DM + n] = (bf16_t)(cvt_pk(h, 0.f) & 0xffffu); }
            sq[j] = h * h;
        }
        mini_rowsum(p.tid, sq, lds);
        if (w == 0 && (lane & 15) == 0 && !p.pad2) {
#pragma unroll
            for (int j = 0; j < 4; ++j) part[(size_t)(m0 + (lane >> 4) * 4 + j) * 16 + g] = sq[j];
        }
    }
}

DEVI void phase_ff1(const Params& p, char* lds, float* rinv) {
    const bf16_t* hb = (const bf16_t*)(p.ws + OFF_HB);
    const bf16_t* Wt = (const bf16_t*)(p.ws + OFF_W) + W_FF1;
    bf16_t* ff = (bf16_t*)(p.ws + OFF_FF);
    const float* part = (const float*)(p.ws + OFF_PART);
    const int lane = p.tid & 63, w = p.tid >> 6, wm = w >> 1, wn = w & 1, hi = lane >> 5, l32 = lane & 31;
    const int ntiles = MT_REAL * 16;
    for (int t = blockIdx.x; t < ntiles; t += gridDim.x) {
        const int mt = t % MT_REAL, nt = t / MT_REAL, m0 = mt * 128, n0 = nt * 256;
        compute_rinv(p.tid, rinv, part, 16, 16, 1024.f, m0);
        f32x16 acc[2][4]; zero_acc<4>(acc);
        gemm_acc<4, 64, 1>(p.tid, hb + (size_t)m0 * DM, DM, Wt + (size_t)n0 * DM, DM, DM, acc, lds);
        const unsigned fo = (unsigned)(m0 + wm * 64 + 4 * hi) * 4096u + (unsigned)(n0 + wn * 128 + l32);
#pragma unroll
        for (int mb = 0; mb < 2; ++mb)
#pragma unroll
            for (int r = 0; r < 16; ++r) {
                const float ri = rinv[wm * 64 + mb * 32 + crow(r, hi)];
                const unsigned o = fo + (unsigned)(mb * 32 + (r & 3) + 8 * (r >> 2)) * 4096u;
#pragma unroll
                for (int nb = 0; nb < 4; ++nb) {
                    const float v = fmaxf(acc[mb][nb][r] * ri, 0.f);
                    ((gbf16_t*)ff)[o + nb * 32] = (bf16_t)(cvt_pk(v * v, 0.f) & 0xffffu);
                }
                if ((r & 3) == 3) __builtin_amdgcn_sched_barrier(0);
            }
    }
    for (int pc = blockIdx.x; pc < 4 * 64; pc += gridDim.x) {
        const int b = pc & 3, g = pc >> 2, m0 = meta_row0(b);
        mini_rinv(p.tid, rinv, part, 16, 16, 1024.f, m0);
        float v[4];
        mini_gemm(p.tid, hb + (size_t)m0 * DM, DM, Wt + (size_t)g * 64 * DM, DM, DM, v, lds);
        const int n = g * 64 + w * 16 + (lane & 15);
#pragma unroll
        for (int j = 0; j < 4; ++j) {
            const int rr = (lane >> 4) * 4 + j;
            const float x = fmaxf(v[j] * rinv[rr], 0.f);
            ff[(size_t)(m0 + rr) * 4096 + n] = (bf16_t)(cvt_pk(x * x, 0.f) & 0xffffu);
        }
    }
}

__global__ void __launch_bounds__(NTHREADS, 2) hybrid_fwd(Params p) {
    __shared__ __attribute__((aligned(16))) char smem[73728];
    __shared__ __attribute__((aligned(16))) float rinv[128];
    __shared__ __attribute__((aligned(16))) int sh[16];
    __shared__ uint4 xb_words;
    if (p.never) cg::this_grid().sync();
    if (threadIdx.x == 0) xb_words = make_uint4(0u, 0u, 0u, 0u);
    __syncthreads();
    XcdBarrier xb;
    if (p.use_bar) xb = xcd_barrier_post((unsigned*)(p.ws + OFF_BAR), (volatile LAS unsigned*)&xb_words);
    for (int ph = p.ph_lo; ph < p.ph_hi; ++ph) {
#ifndef PROBE_REP
#define PROBE_REP -1
#endif
#ifndef ONLYP
#define ONLYP -1
#endif
        constexpr int PER = PROBE_REP >= 0 ? 11 : 10;
        const int layer = ph / PER, si = ph % PER;
        const int s = (PROBE_REP >= 0 && si > PROBE_REP) ? si - 1 : si;
        Params q = p;
        q.tid = threadIdx.x;
        q.pad2 = (PROBE_REP >= 0 && si == PROBE_REP && (s == 4 || s == 7 || s == 9)) ? 1 : 0;
        asm volatile("" : "+s"(q.ws), "+s"(q.out), "+v"(q.tid) :: "memory");
        const bf16_t* Wb = (const bf16_t*)(q.ws + OFF_W);
        switch (s) {
            case 0: if (ONLYP < 0 || ONLYP == 0) phase_prep(q, layer, smem); break;
            case 1: if (ONLYP < 0 || ONLYP == 1) phase_inproj(q, smem, rinv); break;
            case 2: if (ONLYP < 0 || ONLYP == 2) phase_upproj(q, smem, rinv); break;
            case 3: if (ONLYP < 0 || ONLYP == 3) phase_normrope(q, layer, smem); break;
            case 4: if (ONLYP < 0 || ONLYP == 4) phase_attn(q, layer, smem, sh); break;
            case 5: if (ONLYP < 0 || ONLYP == 5) phase_gates(q, layer, smem, rinv); break;
            case 6: if (ONLYP < 0 || ONLYP == 6) phase_merge(q, layer, smem, rinv); break;
            case 7: if (ONLYP < 0 || ONLYP == 7) phase_resid(q, (const bf16_t*)(q.ws + OFF_MERGED), 1024, Wb + W_OUT, smem, layer == 0 ? q.x : q.out); break;
            case 8: if (ONLYP < 0 || ONLYP == 8) phase_ff1(q, smem, rinv); break;
            default: if (ONLYP < 0 || ONLYP == 9) phase_resid(q, (const bf16_t*)(q.ws + OFF_FF), 4096, Wb + W_FF2, smem, q.out); break;
        }
        if (ph + 1 < p.ph_hi && p.use_bar) xcd_barrier(xb);
    }
}

#ifndef ONE_LAUNCH
#define ONE_LAUNCH 1
#endif

extern "C" void kernel_launch(void* const* d_in, const int* in_sizes, int n_in, void* d_out, int out_size, void* d_ws, size_t ws_size, hipStream_t stream) {
    if (ws_size < WS_NEED) { fprintf(stderr, "workspace too small: %zu < %zu\n", ws_size, (size_t)WS_NEED); return; }
    Params p{};
    const float** f = (const float**)&p;
    for (int i = 0; i < 20; ++i) f[i] = (const float*)d_in[i];
    p.out = (float*)d_out; p.ws = (char*)d_ws; p.never = 0;
    hipMemsetAsync(d_ws, 0, ZERO_BYTES, stream);
    const int grid = 512;
#if ONE_LAUNCH
    p.ph_lo = 0; p.ph_hi = (PROBE_REP >= 0) ? 22 : 20; p.use_bar = 1;
    void* args[] = {&p};
    hipError_t e = hipLaunchCooperativeKernel((void*)hybrid_fwd, dim3(grid), dim3(NTHREADS), args, 0, stream);
    if (e != hipSuccess) fprintf(stderr, "cooperative launch failed: %s\n", hipGetErrorString(e));
#else
    for (int ph = 0; ph < 20; ++ph) {
        p.ph_lo = ph; p.ph_hi = ph + 1; p.use_bar = 0;
        hybrid_fwd<<<grid, NTHREADS, 0, stream>>>(p);
    }
#endif
}
```
